# Optimizing an MI355X kernel written in HIP

```python
import jax, jax.numpy as jnp
from jax import lax
import numpy as np

D_MODEL = 1024
BATCH = 4
SEQ = 4096
DEPTH = 2

CHUNK = 64
LEFT_CHUNKS = 8
BAND = (LEFT_CHUNKS + 1) * CHUNK
ATT_HEADS = 8
ATT_HEAD_DIM = 64
ATT_WIDTH = ATT_HEADS * ATT_HEAD_DIM
MAX_REL_DIST = 128
SGU_CHUNK = 128
SGU_GROUPS = 4
SGU_WIDTH = 512
SGU_GROUP_DIM = SGU_WIDTH // SGU_GROUPS
N_BRANCHES = 2
IN_WIDTH = 3 * ATT_WIDTH + 2 * SGU_WIDTH + N_BRANCHES * D_MODEL
D_FF = -(-(8 * D_MODEL) // (3 * 256)) * 256
EPS = 1e-6

kernel_name = "hybrid_chunk_attn_sgu_block"


def rmsnorm(x, g):
    xf = x.astype(jnp.float32)
    xf = xf * lax.rsqrt(jnp.mean(xf * xf, axis=-1, keepdims=True) + EPS)
    return (xf * g.astype(jnp.float32)).astype(x.dtype)


def layernorm(x, g, b):
    xf = x.astype(jnp.float32)
    mu = jnp.mean(xf, axis=-1, keepdims=True)
    var = jnp.mean(jnp.square(xf - mu), axis=-1, keepdims=True)
    y = (xf - mu) * lax.rsqrt(var + EPS) * g.astype(jnp.float32) + b.astype(jnp.float32)
    return y.astype(x.dtype)


def chunked_rel_attention(q, k, v, rel_bias):
    B, S, H, Dh = q.shape
    nc = S // CHUNK
    pad = LEFT_CHUNKS * CHUNK
    qc = q.reshape(B, nc, CHUNK, H, Dh)
    kp = jnp.pad(k, ((0, 0), (pad, 0), (0, 0), (0, 0)))
    vp = jnp.pad(v, ((0, 0), (pad, 0), (0, 0), (0, 0)))
    band_idx = jnp.arange(nc)[:, None] * CHUNK + jnp.arange(BAND)[None, :]
    kb = kp[:, band_idx]
    vb = vp[:, band_idx]
    scores = jnp.einsum('bcqhd,bckhd->bhcqk', qc, kb).astype(jnp.float32) * (Dh ** -0.5)
    q_pos = pad + jnp.arange(CHUNK)
    k_pos = jnp.arange(BAND)
    rel = jnp.clip(q_pos[:, None] - k_pos[None, :], -MAX_REL_DIST, MAX_REL_DIST) + MAX_REL_DIST
    bias = rel_bias.astype(jnp.float32)[:, rel]
    scores = scores + bias[None, :, None, :, :]
    key_chunk = jnp.arange(nc)[:, None] - LEFT_CHUNKS + (k_pos // CHUNK)[None, :]
    valid = key_chunk >= 0
    scores = jnp.where(valid[None, None, :, None, :], scores, jnp.float32(-1e30))
    probs = jax.nn.softmax(scores, axis=-1).astype(v.dtype)
    out = jnp.einsum('bhcqk,bckhd->bcqhd', probs, vb)
    return out.reshape(B, S, H * Dh)


def spatial_gating(u, v, ln_g, ln_b, w_s, b_s):
    B, S, _ = v.shape
    ng = S // SGU_CHUNK
    v = layernorm(v, ln_g, ln_b)
    vg = v.reshape(B, ng, SGU_CHUNK, SGU_GROUPS, SGU_GROUP_DIM)
    causal = jnp.tril(jnp.ones((SGU_CHUNK, SGU_CHUNK), dtype=bool))
    w = jnp.where(causal[None], w_s, jnp.zeros_like(w_s))
    mixed = jnp.einsum('gts,bnsgd->bntgd', w, vg) + b_s.T[None, None, :, :, None]
    return u * mixed.reshape(B, S, SGU_WIDTH)


def setup_inputs(seed: int = 0) -> dict:
    key = jax.random.key(seed)
    ks = jax.random.split(key, 16)
    f32 = jnp.float32

    def nrm(k, shape, scale):
        return jax.random.normal(k, shape, f32) * scale

    x = nrm(ks[0], (BATCH, SEQ, D_MODEL), 1.0)
    norm_mix = 1.0 + nrm(ks[1], (DEPTH, D_MODEL), 0.02)
    w_in = nrm(ks[2], (DEPTH, D_MODEL, IN_WIDTH), D_MODEL ** -0.5)
    att_rel_bias = nrm(ks[3], (DEPTH, ATT_HEADS, 2 * MAX_REL_DIST + 1), 0.1)
    sgu_norm_gain = 1.0 + nrm(ks[4], (DEPTH, SGU_WIDTH), 0.02)
    sgu_norm_bias = nrm(ks[5], (DEPTH, SGU_WIDTH), 0.02)
    sgu_w = nrm(ks[6], (DEPTH, SGU_GROUPS, SGU_CHUNK, SGU_CHUNK), 0.5 * SGU_CHUNK ** -0.5)
    sgu_b = 1.0 + nrm(ks[7], (DEPTH, SGU_GROUPS, SGU_CHUNK), 0.02)
    w_br_att = nrm(ks[8], (DEPTH, ATT_WIDTH, D_MODEL), ATT_WIDTH ** -0.5)
    w_br_sgu = nrm(ks[9], (DEPTH, SGU_WIDTH, D_MODEL), SGU_WIDTH ** -0.5)
    b_gate = nrm(ks[10], (DEPTH, N_BRANCHES, D_MODEL), 0.02)
    w_out = nrm(ks[11], (DEPTH, D_MODEL, D_MODEL), D_MODEL ** -0.5)
    norm_ffn = 1.0 + nrm(ks[12], (DEPTH, D_MODEL), 0.02)
    w_ffn_in = nrm(ks[13], (DEPTH, D_MODEL, 2 * D_FF), D_MODEL ** -0.5)
    w_ffn_out = nrm(ks[14], (DEPTH, D_FF, D_MODEL), D_FF ** -0.5)
    norm_final = 1.0 + nrm(ks[15], (D_MODEL,), 0.02)
    return {"x": x, "norm_mix": norm_mix, "w_in": w_in, "att_rel_bias": att_rel_bias,
            "sgu_norm_gain": sgu_norm_gain, "sgu_norm_bias": sgu_norm_bias,
            "sgu_w": sgu_w, "sgu_b": sgu_b, "w_br_att": w_br_att, "w_br_sgu": w_br_sgu,
            "b_gate": b_gate, "w_out": w_out, "norm_ffn": norm_ffn,
            "w_ffn_in": w_ffn_in, "w_ffn_out": w_ffn_out, "norm_final": norm_final}


def reference(x, norm_mix, w_in, att_rel_bias, sgu_norm_gain, sgu_norm_bias, sgu_w, sgu_b,
              w_br_att, w_br_sgu, b_gate, w_out, norm_ffn, w_ffn_in, w_ffn_out, norm_final):
    B, S, D = x.shape
    h = x
    for l in range(DEPTH):
        xn = rmsnorm(h, norm_mix[l])
        proj = xn @ w_in[l]
        q, k, v, u, vs, gate_logits = jnp.split(
            proj, np.cumsum([ATT_WIDTH, ATT_WIDTH, ATT_WIDTH, SGU_WIDTH, SGU_WIDTH]).tolist(), axis=-1)
        q = q.reshape(B, S, ATT_HEADS, ATT_HEAD_DIM)
        k = k.reshape(B, S, ATT_HEADS, ATT_HEAD_DIM)
        v = v.reshape(B, S, ATT_HEADS, ATT_HEAD_DIM)
        att = chunked_rel_attention(q, k, v, att_rel_bias[l])
        sgu = spatial_gating(jax.nn.gelu(u), jax.nn.gelu(vs), sgu_norm_gain[l], sgu_norm_bias[l],
                             sgu_w[l], sgu_b[l])
        br_att = att @ w_br_att[l]
        br_sgu = sgu @ w_br_sgu[l]
        gates = jax.nn.sigmoid(gate_logits.reshape(B, S, N_BRANCHES, D) + b_gate[l])
        merged = gates[:, :, 0] * br_att + gates[:, :, 1] * br_sgu
        h = h + merged @ w_out[l]
        hn = rmsnorm(h, norm_ffn[l])
        g, up = jnp.split(hn @ w_ffn_in[l], 2, axis=-1)
        h = h + (jax.nn.silu(g) * up) @ w_ffn_out[l]
    return rmsnorm(h, norm_final)
```

```cpp
#include <hip/hip_runtime.h>
#include <cstdio>
#include <cstdint>

namespace nv {
constexpr int D = 1024, BATCH = 4, SEQ = 4096, DEPTH = 2;
constexpr int CHUNK = 64, LEFT = 8, BAND = 576, H = 8, HD = 64, AW = 512, MAXREL = 128;
constexpr int SGC = 128, SGG = 4, SGW = 512, SGD = 128;
constexpr int INW = 4608, DFF = 2816;
constexpr float EPS = 1e-6f;

__device__ __forceinline__ float wsum(float v) {
#pragma unroll
    for (int o = 32; o > 0; o >>= 1) v += __shfl_xor(v, o);
    return v;
}
__device__ __forceinline__ float wmax(float v) {
#pragma unroll
    for (int o = 32; o > 0; o >>= 1) v = fmaxf(v, __shfl_xor(v, o));
    return v;
}
__device__ __forceinline__ float gelu_t(float x) { return 0.5f * x * (1.f + tanhf(0.7978845608028654f * (x + 0.044715f * x * x * x))); }

__global__ void __launch_bounds__(256) rmsnorm_k(const float* x, const float* __restrict__ g, float* out, int rows) {
    const int row = blockIdx.x * 4 + (threadIdx.x >> 6), lane = threadIdx.x & 63;
    if (row >= rows) return;
    const float4* xr = (const float4*)(x + (size_t)row * D);
    float4 v[4]; float s = 0.f;
#pragma unroll
    for (int j = 0; j < 4; ++j) { v[j] = xr[lane + 64 * j]; s += v[j].x * v[j].x + v[j].y * v[j].y + v[j].z * v[j].z + v[j].w * v[j].w; }
    const float r = 1.0f / sqrtf(wsum(s) * (1.f / D) + EPS);
    float4* o = (float4*)(out + (size_t)row * D); const float4* gg = (const float4*)g;
#pragma unroll
    for (int j = 0; j < 4; ++j) { float4 q = gg[lane + 64 * j]; float4 w; w.x = v[j].x * r * q.x; w.y = v[j].y * r * q.y; w.z = v[j].z * r * q.z; w.w = v[j].w * r * q.w; o[lane + 64 * j] = w; }
}

__global__ void __launch_bounds__(256) gemm_k(const float* __restrict__ A, int lda, const float* __restrict__ B, int ldb, float* __restrict__ C, int ldc, int K, int accum) {
    __shared__ float As[16][132];
    __shared__ float Bs[16][132];
    const int tid = threadIdx.x, tx = tid & 15, ty = tid >> 4;
    const int bm = blockIdx.y * 128, bn = blockIdx.x * 128;
    float acc[8][8];
#pragma unroll
    for (int i = 0; i < 8; ++i)
#pragma unroll
        for (int j = 0; j < 8; ++j) acc[i][j] = 0.f;
    for (int k0 = 0; k0 < K; k0 += 16) {
#pragma unroll
        for (int i = 0; i < 2; ++i) {
            const int idx = tid + i * 256, r = idx >> 2, c4 = idx & 3;
            const float4 v = *(const float4*)(A + (size_t)(bm + r) * lda + k0 + c4 * 4);
            As[c4 * 4 + 0][r] = v.x; As[c4 * 4 + 1][r] = v.y; As[c4 * 4 + 2][r] = v.z; As[c4 * 4 + 3][r] = v.w;
        }
#pragma unroll
        for (int i = 0; i < 2; ++i) {
            const int idx = tid + i * 256, r = idx >> 5, c4 = idx & 31;
            const float4 v = *(const float4*)(B + (size_t)(k0 + r) * ldb + bn + c4 * 4);
            *(float4*)&Bs[r][c4 * 4] = v;
        }
        __syncthreads();
#pragma unroll
        for (int k = 0; k < 16; ++k) {
            float a[8], b[8];
            const float4 a0 = *(const float4*)&As[k][ty * 8], a1 = *(const float4*)&As[k][ty * 8 + 4];
            const float4 b0 = *(const float4*)&Bs[k][tx * 8], b1 = *(const float4*)&Bs[k][tx * 8 + 4];
            a[0] = a0.x; a[1] = a0.y; a[2] = a0.z; a[3] = a0.w; a[4] = a1.x; a[5] = a1.y; a[6] = a1.z; a[7] = a1.w;
            b[0] = b0.x; b[1] = b0.y; b[2] = b0.z; b[3] = b0.w; b[4] = b1.x; b[5] = b1.y; b[6] = b1.z; b[7] = b1.w;
#pragma unroll
            for (int i = 0; i < 8; ++i)
#pragma unroll
                for (int j = 0; j < 8; ++j) acc[i][j] = fmaf(a[i], b[j], acc[i][j]);
        }
        __syncthreads();
    }
#pragma unroll
    for (int i = 0; i < 8; ++i) {
        float* cp = C + (size_t)(bm + ty * 8 + i) * ldc + bn + tx * 8;
        float4 o0, o1;
        if (accum) { o0 = *(float4*)cp; o1 = *(float4*)(cp + 4); } else { o0 = make_float4(0, 0, 0, 0); o1 = o0; }
        o0.x += acc[i][0]; o0.y += acc[i][1]; o0.z += acc[i][2]; o0.w += acc[i][3];
        o1.x += acc[i][4]; o1.y += acc[i][5]; o1.z += acc[i][6]; o1.w += acc[i][7];
        *(float4*)cp = o0; *(float4*)(cp + 4) = o1;
    }
}

__global__ void __launch_bounds__(64) attn_k(const float* __restrict__ proj, const float* __restrict__ relb  , float* __restrict__ att) {
    __shared__ float qs[64];
    __shared__ float ps[BAND];
    const int s = blockIdx.x, h = blockIdx.y, lane = threadIdx.x;
    const int c = s / CHUNK, qi = s % CHUNK;
    qs[lane] = proj[(size_t)s * INW + h * HD + lane];
    __syncthreads();
    float sc[9]; float mx = -3.0e38f;
#pragma unroll
    for (int t = 0; t < 9; ++t) {
        const int j = t * 64 + lane;
        const int kp = c * CHUNK - LEFT * CHUNK + j;
        float v = -1e30f;
        if (kp >= 0) {
            const float* kr = proj + (size_t)kp * INW + AW + h * HD;
            float d = 0.f;
            for (int e = 0; e < HD; ++e) d = fmaf(qs[e], kr[e], d);
            int rel = (LEFT * CHUNK + qi) - j; rel = rel < -MAXREL ? -MAXREL : (rel > MAXREL ? MAXREL : rel);
            v = d * 0.125f + relb[h * (2 * MAXREL + 1) + rel + MAXREL];
        }
        sc[t] = v; mx = fmaxf(mx, v);
    }
    mx = wmax(mx);
    float sum = 0.f;
#pragma unroll
    for (int t = 0; t < 9; ++t) { sc[t] = expf(sc[t] - mx); sum += sc[t]; }
    sum = wsum(sum);
    const float inv = 1.f / sum;
#pragma unroll
    for (int t = 0; t < 9; ++t) ps[t * 64 + lane] = sc[t] * inv;
    __syncthreads();
    float o = 0.f;
    const int j0 = (c >= LEFT) ? 0 : (LEFT - c) * CHUNK;
    for (int j = j0; j < BAND; ++j) {
        const int kp = c * CHUNK - LEFT * CHUNK + j;
        o = fmaf(ps[j], proj[(size_t)kp * INW + 2 * AW + h * HD + lane], o);
    }
    att[(size_t)s * AW + h * HD + lane] = o;
}

__global__ void __launch_bounds__(256) sgu_pre_k(const float* __restrict__ proj, const float* __restrict__ lg, const float* __restrict__ lb, float* __restrict__ ug, float* __restrict__ vln, int rows) {
    const int row = blockIdx.x * 4 + (threadIdx.x >> 6), lane = threadIdx.x & 63;
    if (row >= rows) return;
    const float* u = proj + (size_t)row * INW + 3 * AW;
    const float* vs = u + SGW;
    float v[8]; float s = 0.f;
#pragma unroll
    for (int j = 0; j < 8; ++j) { ug[(size_t)row * SGW + lane + 64 * j] = gelu_t(u[lane + 64 * j]); v[j] = gelu_t(vs[lane + 64 * j]); s += v[j]; }
    const float mu = wsum(s) * (1.f / SGW); float q = 0.f;
#pragma unroll
    for (int j = 0; j < 8; ++j) { v[j] -= mu; q += v[j] * v[j]; }
    const float r = 1.0f / sqrtf(wsum(q) * (1.f / SGW) + EPS);
#pragma unroll
    for (int j = 0; j < 8; ++j) vln[(size_t)row * SGW + lane + 64 * j] = v[j] * r * lg[lane + 64 * j] + lb[lane + 64 * j];
}
__global__ void __launch_bounds__(256) sgu_mix_k(const float* __restrict__ ug, const float* __restrict__ vln, const float* __restrict__ w  , const float* __restrict__ bs  , float* __restrict__ out) {
    const int row = blockIdx.x, t = row % SGC, r0 = row - t;
    for (int c = threadIdx.x; c < SGW; c += 256) {
        const int g = c / SGD;
        const float* wr = w + ((size_t)g * SGC + t) * SGC;
        float a = 0.f;
        for (int s = 0; s <= t; ++s) a = fmaf(wr[s], vln[(size_t)(r0 + s) * SGW + c], a);
        out[(size_t)row * SGW + c] = ug[(size_t)row * SGW + c] * (a + bs[g * SGC + t]);
    }
}
__global__ void __launch_bounds__(256) merge_k(const float* __restrict__ proj, const float* __restrict__ bg  , float* __restrict__ bra, const float* __restrict__ brs, int rows) {
    const size_t i = (size_t)blockIdx.x * 256 + threadIdx.x;
    if (i >= (size_t)rows * D) return;
    const int row = (int)(i / D), c = (int)(i % D);
    const float l0 = proj[(size_t)row * INW + 3 * AW + 2 * SGW + c] + bg[c];
    const float l1 = proj[(size_t)row * INW + 3 * AW + 2 * SGW + D + c] + bg[D + c];
    const float g0 = 1.f / (1.f + expf(-l0)), g1 = 1.f / (1.f + expf(-l1));
    bra[i] = g0 * bra[i] + g1 * brs[i];
}
__global__ void __launch_bounds__(256) swiglu_k(const float* __restrict__ gu  , float* __restrict__ act, int rows) {
    const size_t i = (size_t)blockIdx.x * 256 + threadIdx.x;
    if (i >= (size_t)rows * DFF) return;
    const int row = (int)(i / DFF), c = (int)(i % DFF);
    const float g = gu[(size_t)row * 2 * DFF + c], u = gu[(size_t)row * 2 * DFF + DFF + c];
    act[i] = g / (1.f + expf(-g)) * u;
}
__global__ void __launch_bounds__(256) copy_k(const float4* __restrict__ a, float4* __restrict__ b, size_t n4) {
    const size_t i = (size_t)blockIdx.x * 256 + threadIdx.x;
    if (i < n4) b[i] = a[i];
}
}

extern "C" void kernel_launch(void* const* d_in, const int* in_sizes, int n_in, void* d_out, int out_size, void* d_ws, size_t ws_size, hipStream_t stream) {
    using namespace nv;
    const float* x = (const float*)d_in[0];
    const float* norm_mix = (const float*)d_in[1];
    const float* w_in = (const float*)d_in[2];
    const float* relb = (const float*)d_in[3];
    const float* sg_g = (const float*)d_in[4];
    const float* sg_b = (const float*)d_in[5];
    const float* sg_w = (const float*)d_in[6];
    const float* sg_bs = (const float*)d_in[7];
    const float* w_bra = (const float*)d_in[8];
    const float* w_brs = (const float*)d_in[9];
    const float* b_gate = (const float*)d_in[10];
    const float* w_out = (const float*)d_in[11];
    const float* norm_ffn = (const float*)d_in[12];
    const float* w_fi = (const float*)d_in[13];
    const float* w_fo = (const float*)d_in[14];
    const float* norm_final = (const float*)d_in[15];
    float* out = (float*)d_out;
    float* ws = (float*)d_ws;
    const size_t MiBf = (1u << 20) / 4;
    float* XN = ws;
    float* PROJ = ws + 16 * MiBf;
    float* ATT = ws + 104 * MiBf;
    float* UG = ws + 112 * MiBf;
    float* VLN = ws + 120 * MiBf;
    float* SG = ws + 128 * MiBf;
    float* BRA = ws + 136 * MiBf;
    float* BRS = ws + 152 * MiBf;
    float* ACT = ws + 168 * MiBf;
    for (int b = 0; b < BATCH; ++b) {
        const float* xb = x + (size_t)b * SEQ * D;
        float* hb = out + (size_t)b * SEQ * D;
        copy_k<<<(SEQ * D / 4 + 255) / 256, 256, 0, stream>>>((const float4*)xb, (float4*)hb, (size_t)SEQ * D / 4);
        for (int l = 0; l < DEPTH; ++l) {
            rmsnorm_k<<<SEQ / 4, 256, 0, stream>>>(hb, norm_mix + l * D, XN, SEQ);
            gemm_k<<<dim3(INW / 128, SEQ / 128), 256, 0, stream>>>(XN, D, w_in + (size_t)l * D * INW, INW, PROJ, INW, D, 0);
            attn_k<<<dim3(SEQ, H), 64, 0, stream>>>(PROJ, relb + (size_t)l * H * (2 * MAXREL + 1), ATT);
            sgu_pre_k<<<SEQ / 4, 256, 0, stream>>>(PROJ, sg_g + l * SGW, sg_b + l * SGW, UG, VLN, SEQ);
            sgu_mix_k<<<SEQ, 256, 0, stream>>>(UG, VLN, sg_w + (size_t)l * SGG * SGC * SGC, sg_bs + l * SGG * SGC, SG);
            gemm_k<<<dim3(D / 128, SEQ / 128), 256, 0, stream>>>(ATT, AW, w_bra + (size_t)l * AW * D, D, BRA, D, AW, 0);
            gemm_k<<<dim3(D / 128, SEQ / 128), 256, 0, stream>>>(SG, SGW, w_brs + (size_t)l * SGW * D, D, BRS, D, SGW, 0);
            merge_k<<<SEQ * D / 256, 256, 0, stream>>>(PROJ, b_gate + (size_t)l * 2 * D, BRA, BRS, SEQ);
            gemm_k<<<dim3(D / 128, SEQ / 128), 256, 0, stream>>>(BRA, D, w_out + (size_t)l * D * D, D, hb, D, D, 1);
            rmsnorm_k<<<SEQ / 4, 256, 0, stream>>>(hb, norm_ffn + l * D, XN, SEQ);
            gemm_k<<<dim3(2 * DFF / 128, SEQ / 128), 256, 0, stream>>>(XN, D, w_fi + (size_t)l * D * 2 * DFF, 2 * DFF, PROJ, 2 * DFF, D, 0);
            swiglu_k<<<(SEQ * DFF + 255) / 256, 256, 0, stream>>>(PROJ, ACT, SEQ);
            gemm_k<<<dim3(D / 128, SEQ / 128), 256, 0, stream>>>(ACT, DFF, w_fo + (size_t)l * DFF * D, D, hb, D, DFF, 1);
        }
        rmsnorm_k<<<SEQ / 4, 256, 0, stream>>>(hb, norm_final, hb, SEQ);
    }
}
```

```cpp
#include <hip/hip_runtime.h>
#include <cstdio>
#include <cstdint>

#ifndef MK_LAUNCHES
#define MK_LAUNCHES 1
#endif

#define LAS __attribute__((address_space(3)))
#define GAS __attribute__((address_space(1)))
typedef unsigned short bf16_t;
typedef short bf16x8 __attribute__((ext_vector_type(8)));
typedef short s16x4 __attribute__((ext_vector_type(4)));
typedef float f32x2 __attribute__((ext_vector_type(2)));
typedef float f32x4 __attribute__((ext_vector_type(4)));
typedef float f32x16 __attribute__((ext_vector_type(16)));
typedef unsigned u32x2 __attribute__((ext_vector_type(2)));
typedef unsigned u32x4 __attribute__((ext_vector_type(4)));
typedef __bf16 bf16x2_t __attribute__((ext_vector_type(2)));
typedef _Float16 f16x2_t __attribute__((ext_vector_type(2)));

constexpr int M = 16384, D = 1024, SEQ = 4096, NBATCH = 4, DEPTH = 2;
constexpr int AW = 512, SW = 512, INW = 4608, DFF = 2816, NH = 8;
constexpr float EPS = 1e-6f;
constexpr float LOG2E = 1.4426950408889634f;
constexpr float QSCALE = 0.125f * LOG2E;
constexpr int NWAVES = 8, NTHREADS = 512;

constexpr size_t MiB = 1u << 20;
constexpr size_t WS_CTL = 0, CTL_ZERO_BYTES = 64 * 1024;
constexpr size_t WS_STATS = 1 * MiB;
constexpr size_t WS_SGWB = 1 * MiB + 512 * 1024;
constexpr size_t WS_R2 = 1 * MiB + 768 * 1024;
constexpr size_t WS_W = 2 * MiB, W_LAYER = 30 * MiB;
constexpr size_t W_IN = 0, W_BR = 9 * MiB, W_OUT = 11 * MiB, W_FI = 13 * MiB, W_FO = 24 * MiB;
constexpr size_t WS_XN = 64 * MiB;
constexpr size_t WS_Q = 96 * MiB, WS_K = 112 * MiB, WS_VT = 128 * MiB, WS_UG = 144 * MiB, WS_VGT = 160 * MiB, WS_G0 = 176 * MiB, WS_G1 = 208 * MiB;
constexpr size_t WS_MG = 96 * MiB;
constexpr size_t WS_ACT = 96 * MiB;
constexpr size_t WS_END = 240 * MiB;
constexpr int CW_BAR = 1024;

__device__ __forceinline__ unsigned pk_bf16(float lo, float hi) { f32x2 v = {lo, hi}; bf16x2_t b = __builtin_convertvector(v, bf16x2_t); return __builtin_bit_cast(unsigned, b); }
__device__ __forceinline__ unsigned pk_f16(float lo, float hi) { f32x2 v = {lo, hi}; f16x2_t b = __builtin_convertvector(v, f16x2_t); return __builtin_bit_cast(unsigned, b); }
__device__ __forceinline__ float bf_lo(unsigned w) { return __uint_as_float(w << 16); }
__device__ __forceinline__ float bf_hi(unsigned w) { return __uint_as_float(w & 0xffff0000u); }
__device__ __forceinline__ float h_lo(unsigned w) { f16x2_t h = __builtin_bit_cast(f16x2_t, w); return (float)h[0]; }
__device__ __forceinline__ float h_hi(unsigned w) { f16x2_t h = __builtin_bit_cast(f16x2_t, w); return (float)h[1]; }
__device__ __forceinline__ float fexp2(float x) { return __builtin_amdgcn_exp2f(x); }
__device__ __forceinline__ float frcp(float x) { return __builtin_amdgcn_rcpf(x); }
__device__ __forceinline__ float sigmoidf_(float z) { return frcp(1.f + fexp2(-LOG2E * z)); }
__device__ __forceinline__ float gelu_tanh(float x) { const float t = x * (1.f + 0.044715f * x * x) * (-2.302208198f); return x * frcp(1.f + fexp2(t)); }
__device__ __forceinline__ float wave_sum(float v) {
#pragma unroll
    for (int o = 1; o < 64; o <<= 1) v += __shfl_xor(v, o);
    return v;
}
__device__ __forceinline__ int crow(int r, int hi) { return (r & 3) + 8 * (r >> 2) + 4 * hi; }

namespace pg8 {
constexpr int BM = 256, BK = 64, HALF = 128, HTB = HALF * BK * 2, STAGE_BYTES = 8 * HTB;
__host__ __device__ __forceinline__ int lds_byte(int r, int c) { const int st = (r >> 4) * 2 + (c >> 5), rr = r & 15, cc = c & 31, ob = rr * 64 + cc * 2; return st * 1024 + (ob ^ (((ob >> 9) & 1) << 5)); }
__host__ __device__ __forceinline__ void stage_rc(int b, int& R, int& C) { const int st = b / 1024, sb = b % 1024, swz = sb ^ (((sb >> 9) & 1) << 5); R = (st >> 1) * 16 + swz / 64; C = (st & 1) * 32 + (swz % 64) / 2; }
__host__ __device__ __forceinline__ int perm32(int rho) { const int n = rho >> 4, i = rho & 15; return 8 * (i >> 2) + 4 * n + (i & 3); }

struct Unit { const char* A; const char* B; int kind, r0, c0; };

template <class Epi, class Sched>
__device__ __forceinline__ void gemm_phase(LAS unsigned char* lds, const int K, const Sched& S, const Epi& E) {
    int tid = threadIdx.x; asm volatile("" : "+v"(tid));
    const int wid = __builtin_amdgcn_readfirstlane(tid >> 6), lane = tid & 63, wr = wid >> 2, wc = wid & 3, fr = lane & 15, fq = lane >> 4;
    const int nt = K / BK;
    unsigned voffA[2], voffB[2];
#pragma unroll
    for (int i = 0; i < 2; ++i) { int R, C; stage_rc(tid * 16 + i * 8192, R, C); const int Rb = (R & ~31) + perm32(R & 31);
        voffA[i] = (unsigned)(R * K + C) * 2u; voffB[i] = (unsigned)(Rb * K + C) * 2u; }
    const size_t kstep = (size_t)(BK * 2);
    const size_t hstep = (size_t)HALF * K * 2;
    const unsigned ldsw = (unsigned)wid * 1024u;
    const int aoff = lds_byte(wr * 64 + fr, fq * 8), boff = lds_byte(wc * 32 + fr, fq * 8);
#define PG8_SA(b, h) (((b) * 2 + (h)) * HTB)
#define PG8_SB(b, h) ((4 + (b) * 2 + (h)) * HTB)
#define PG8_STAGE(bufoff, gbase, voff) do { _Pragma("unroll") for (int _i = 0; _i < 2; ++_i) \
        __builtin_amdgcn_global_load_lds((const unsigned*)((const char*)(gbase) + (voff)[_i]), (LAS unsigned*)(lds + (bufoff) + ldsw + _i * 8192), 16, 0, 0); } while (0)
#define PG8_LDA(dst, b, h) do { _Pragma("unroll") for (int m = 0; m < 4; ++m) _Pragma("unroll") for (int k = 0; k < 2; ++k) dst[m][k] = *(const LAS bf16x8*)(lds + PG8_SA(b, h) + aoff + m * 2048 + k * 1024); } while (0)
#define PG8_LDB(dst, b, h) do { _Pragma("unroll") for (int n = 0; n < 2; ++n) _Pragma("unroll") for (int k = 0; k < 2; ++k) dst[n][k] = *(const LAS bf16x8*)(lds + PG8_SB(b, h) + boff + n * 2048 + k * 1024); } while (0)
#define PG8_MMA(ai, bj, At, Bt) do { __builtin_amdgcn_s_setprio(1); _Pragma("unroll") for (int m = 0; m < 4; ++m) _Pragma("unroll") for (int n = 0; n < 2; ++n) _Pragma("unroll") for (int k = 0; k < 2; ++k) \
        acc[ai][bj][m][n] = __builtin_amdgcn_mfma_f32_16x16x32_bf16(Bt[n][k], At[m][k], acc[ai][bj][m][n], 0, 0, 0); __builtin_amdgcn_s_setprio(0); } while (0)
#define PG8_WAIT_V(n) asm volatile("s_waitcnt vmcnt(" #n ")" ::: "memory")
#define PG8_WAIT_L(n) asm volatile("s_waitcnt lgkmcnt(" #n ")" ::: "memory")
#define PG8_BAR __builtin_amdgcn_s_barrier()
#define PG8_SCHED __builtin_amdgcn_sched_barrier(0)
    Unit cur, nxt; int ui = 0;
    if (!S.next(0, cur)) return;
    f32x4 acc[2][2][4][2];
#pragma unroll
    for (int a = 0; a < 2; ++a)
#pragma unroll
        for (int b = 0; b < 2; ++b)
#pragma unroll
            for (int m = 0; m < 4; ++m)
#pragma unroll
                for (int n = 0; n < 2; ++n) acc[a][b][m][n] = (f32x4){0.f, 0.f, 0.f, 0.f};
    bf16x8 At[4][2], B0[2][2], B1[2][2];
    const char* cA = cur.A; const char* cB = cur.B;
    PG8_STAGE(PG8_SB(0, 0), cB, voffB); PG8_STAGE(PG8_SB(0, 1), cB + hstep, voffB); PG8_STAGE(PG8_SA(0, 0), cA, voffA); PG8_STAGE(PG8_SA(0, 1), cA + hstep, voffA);
    if (wr == 1) PG8_BAR;
    PG8_WAIT_V(2); PG8_BAR;
    PG8_STAGE(PG8_SB(1, 0), cB + kstep, voffB); PG8_STAGE(PG8_SA(1, 0), cA + kstep, voffA); PG8_STAGE(PG8_SB(1, 1), cB + hstep + kstep, voffB);
    PG8_WAIT_V(6); PG8_BAR;
    for (;;) {
        const bool has_next = S.next(ui + 1, nxt);
        const char* nA = has_next ? nxt.A : cA; const char* nB = has_next ? nxt.B : cB;
        for (int t = 0; t < nt; t += 2) {
            if (Epi::MID_T > 0 && t == Epi::MID_T) E.mid(acc, cur, wr, wc, fr, fq);
            const bool last = (t == nt - 2);
            const char* a1 = cA + (size_t)(t + 1) * kstep;
            const char* a2 = last ? nA : cA + (size_t)(t + 2) * kstep; const char* b2 = last ? nB : cB + (size_t)(t + 2) * kstep;
            const char* a3 = a2 + kstep; const char* b3 = b2 + kstep;
            PG8_LDB(B0, 0, 0); PG8_LDB(B1, 0, 1); PG8_SCHED; PG8_LDA(At, 0, 0); PG8_STAGE(PG8_SA(1, 1), a1 + hstep, voffA);
            PG8_WAIT_V(8); PG8_WAIT_L(0); PG8_BAR; PG8_MMA(0, 0, At, B0); PG8_MMA(0, 1, At, B1); PG8_BAR; PG8_SCHED;
            PG8_LDA(At, 0, 1); PG8_STAGE(PG8_SB(0, 0), b2, voffB); PG8_STAGE(PG8_SB(0, 1), b2 + hstep, voffB); PG8_STAGE(PG8_SA(0, 0), a2, voffA);
            PG8_WAIT_V(8); PG8_WAIT_L(0); PG8_BAR; PG8_MMA(1, 0, At, B0); PG8_MMA(1, 1, At, B1); PG8_BAR; PG8_SCHED;
            PG8_LDB(B0, 1, 0); PG8_LDB(B1, 1, 1); PG8_SCHED; PG8_LDA(At, 1, 0); PG8_STAGE(PG8_SA(0, 1), a2 + hstep, voffA);
            PG8_WAIT_V(8); PG8_WAIT_L(0); PG8_BAR; PG8_MMA(0, 0, At, B0); PG8_MMA(0, 1, At, B1); PG8_BAR; PG8_SCHED;
            PG8_LDA(At, 1, 1); PG8_STAGE(PG8_SB(1, 0), b3, voffB); PG8_STAGE(PG8_SB(1, 1), b3 + hstep, voffB); PG8_STAGE(PG8_SA(1, 0), a3, voffA);
            PG8_WAIT_V(8); PG8_WAIT_L(0); PG8_BAR; PG8_MMA(1, 0, At, B0); PG8_MMA(1, 1, At, B1); PG8_BAR; PG8_SCHED;
        }
        if (wr == 0) PG8_BAR;
        E(acc, cur, wr, wc, fr, fq);
        if (!has_next) break;
#pragma unroll
        for (int a = 0; a < 2; ++a)
#pragma unroll
            for (int b = 0; b < 2; ++b)
#pragma unroll
                for (int m = 0; m < 4; ++m)
#pragma unroll
                    for (int n = 0; n < 2; ++n) acc[a][b][m][n] = (f32x4){0.f, 0.f, 0.f, 0.f};
        cur = nxt; cA = nA; cB = nB; ++ui;
        if (wr == 1) PG8_BAR;
    }
    PG8_WAIT_V(0);
    PG8_BAR;
#undef PG8_SA
#undef PG8_SB
#undef PG8_STAGE
#undef PG8_LDA
#undef PG8_LDB
#undef PG8_MMA
#undef PG8_WAIT_V
#undef PG8_WAIT_L
#undef PG8_BAR
#undef PG8_SCHED
}
}
using pg8::Unit;

enum { K_Q = 0, K_K = 1, K_U = 2, K_G0 = 3, K_G1 = 4, K_VT = 5, K_VGT = 6 };

struct Epi1 {
    static constexpr int MID_T = 0;
    bf16_t *Q, *Kb, *VT, *UG, *VGT; unsigned short *G0, *G1; const float* bgate; f32x2* stats;
    __device__ __forceinline__ void mid(f32x4 (&)[2][2][4][2], const Unit&, int, int, int, int) const {}
    __device__ __forceinline__ void operator()(const f32x4 (&acc)[2][2][4][2], const Unit& u, int wr, int wc, int fr, int fq) const {
        const int kind = u.kind;
        const int rowb = u.r0 + wr * 64 + fr, colb = u.c0 + wc * 32 + 8 * fq;
        if (kind == K_Q || kind == K_K || kind == K_U) {
            bf16_t* O = kind == K_Q ? Q : (kind == K_K ? Kb : UG);
            const float sc = kind == K_Q ? QSCALE : 1.f;
#pragma unroll
            for (int ai = 0; ai < 2; ++ai)
#pragma unroll
                for (int m = 0; m < 4; ++m) { bf16_t* rowp = O + (size_t)(rowb + ai * 128 + m * 16) * 512 + colb;
#pragma unroll
                    for (int bj = 0; bj < 2; ++bj) { f32x4 v0 = acc[ai][bj][m][0], v1 = acc[ai][bj][m][1];
                        if (kind == K_U) {
#pragma unroll
                            for (int e = 0; e < 4; ++e) { v0[e] = gelu_tanh(v0[e]); v1[e] = gelu_tanh(v1[e]); } }
                        else { v0 = v0 * sc; v1 = v1 * sc; }
                        u32x4 w; w.x = pk_bf16(v0[0], v0[1]); w.y = pk_bf16(v0[2], v0[3]); w.z = pk_bf16(v1[0], v1[1]); w.w = pk_bf16(v1[2], v1[3]);
                        *(u32x4*)(rowp + bj * 128) = w; } }
        } else if (kind == K_G0 || kind == K_G1) {
            unsigned short* O = kind == K_G0 ? G0 : G1; const float* bg = bgate + (kind == K_G0 ? 0 : D);
            f32x4 bv[2][2];
#pragma unroll
            for (int bj = 0; bj < 2; ++bj) { bv[bj][0] = *(const f32x4*)(bg + colb + bj * 128); bv[bj][1] = *(const f32x4*)(bg + colb + bj * 128 + 4); }
#pragma unroll
            for (int ai = 0; ai < 2; ++ai)
#pragma unroll
                for (int m = 0; m < 4; ++m) { unsigned short* rowp = O + (size_t)(rowb + ai * 128 + m * 16) * 1024 + colb;
#pragma unroll
                    for (int bj = 0; bj < 2; ++bj) { f32x4 v0 = acc[ai][bj][m][0] + bv[bj][0], v1 = acc[ai][bj][m][1] + bv[bj][1];
#pragma unroll
                        for (int e = 0; e < 4; ++e) { v0[e] = sigmoidf_(v0[e]); v1[e] = sigmoidf_(v1[e]); }
                        u32x4 w; w.x = pk_f16(v0[0], v0[1]); w.y = pk_f16(v0[2], v0[3]); w.z = pk_f16(v1[0], v1[1]); w.w = pk_f16(v1[2], v1[3]);
                        *(u32x4*)(rowp + bj * 128) = w; } }
        } else if (kind == K_VT) {
            const int cb = u.c0 + wc * 32 + 16 * (fq >> 1) + 4 * (fq & 1);
#pragma unroll
            for (int ai = 0; ai < 2; ++ai)
#pragma unroll
                for (int m = 0; m < 4; ++m) { bf16_t* rowp = VT + (size_t)(rowb + ai * 128 + m * 16) * M + cb;
#pragma unroll
                    for (int bj = 0; bj < 2; ++bj) { const f32x4 v0 = acc[ai][bj][m][0], v1 = acc[ai][bj][m][1];
                        u32x2 w0, w1; w0.x = pk_bf16(v0[0], v0[1]); w0.y = pk_bf16(v0[2], v0[3]); w1.x = pk_bf16(v1[0], v1[1]); w1.y = pk_bf16(v1[2], v1[3]);
                        *(u32x2*)(rowp + bj * 128) = w0; *(u32x2*)(rowp + bj * 128 + 8) = w1; } }
        } else {
            const int slot = (u.r0 >> 8) * 2 + wr;
#pragma unroll
            for (int bj = 0; bj < 2; ++bj) {
                f32x4 s0 = (f32x4){0.f, 0.f, 0.f, 0.f}, s1 = s0, q0 = s0, q1 = s0;
#pragma unroll
                for (int ai = 0; ai < 2; ++ai)
#pragma unroll
                    for (int m = 0; m < 4; ++m) { f32x4 v0 = acc[ai][bj][m][0], v1 = acc[ai][bj][m][1];
#pragma unroll
                        for (int e = 0; e < 4; ++e) { v0[e] = gelu_tanh(v0[e]); v1[e] = gelu_tanh(v1[e]); }
                        s0 += v0; s1 += v1; q0 += v0 * v0; q1 += v1 * v1;
                        u32x4 w; w.x = pk_bf16(v0[0], v0[1]); w.y = pk_bf16(v0[2], v0[3]); w.z = pk_bf16(v1[0], v1[1]); w.w = pk_bf16(v1[2], v1[3]);
                        *(u32x4*)(VGT + (size_t)(rowb + ai * 128 + m * 16) * M + colb + bj * 128) = w; }
#pragma unroll
                for (int e = 0; e < 4; ++e) { float a = s0[e], b = q0[e], c = s1[e], d = q1[e];
#pragma unroll
                    for (int o = 1; o < 16; o <<= 1) { a += __shfl_xor(a, o); b += __shfl_xor(b, o); c += __shfl_xor(c, o); d += __shfl_xor(d, o); }
                    if (fr == 0) { stats[(size_t)(colb + bj * 128 + e) * 4 + slot] = (f32x2){a, b}; stats[(size_t)(colb + bj * 128 + 4 + e) * 4 + slot] = (f32x2){c, d}; } }
                asm volatile("" ::: "memory");
            }
        }
    }
};

struct Epi2 {
    static constexpr int MID_T = 8;
    const unsigned short *G0, *G1; bf16_t* MG;
    __device__ __forceinline__ void mid(f32x4 (&acc)[2][2][4][2], const Unit& u, int wr, int wc, int fr, int fq) const {
        int rowb = u.r0 + wr * 64 + fr, colb = u.c0 + wc * 32 + 8 * fq;
        asm volatile("" : "+v"(rowb), "+v"(colb));
#pragma unroll
        for (int ai = 0; ai < 2; ++ai)
#pragma unroll
            for (int m = 0; m < 4; ++m) { const size_t off = (size_t)(rowb + ai * 128 + m * 16) * 1024 + colb;
#pragma unroll
                for (int bj = 0; bj < 2; ++bj) { const u32x4 a = *(const u32x4*)(G0 + off + bj * 128), b = *(const u32x4*)(G1 + off + bj * 128);
                    f32x4 r0, r1;
                    r0[0] = h_lo(a.x) * frcp(h_lo(b.x)); r0[1] = h_hi(a.x) * frcp(h_hi(b.x)); r0[2] = h_lo(a.y) * frcp(h_lo(b.y)); r0[3] = h_hi(a.y) * frcp(h_hi(b.y));
                    r1[0] = h_lo(a.z) * frcp(h_lo(b.z)); r1[1] = h_hi(a.z) * frcp(h_hi(b.z)); r1[2] = h_lo(a.w) * frcp(h_lo(b.w)); r1[3] = h_hi(a.w) * frcp(h_hi(b.w));
                    acc[ai][bj][m][0] *= r0; acc[ai][bj][m][1] *= r1; }
                asm volatile("" ::: "memory"); }
    }
    __device__ __forceinline__ void operator()(const f32x4 (&acc)[2][2][4][2], const Unit& u, int wr, int wc, int fr, int fq) const {
        const int rowb = u.r0 + wr * 64 + fr, colb = u.c0 + wc * 32 + 8 * fq;
#pragma unroll
        for (int ai = 0; ai < 2; ++ai)
#pragma unroll
            for (int m = 0; m < 4; ++m) { const size_t off = (size_t)(rowb + ai * 128 + m * 16) * 1024 + colb;
#pragma unroll
                for (int bj = 0; bj < 2; ++bj) { const u32x4 b = *(const u32x4*)(G1 + off + bj * 128);
                    const f32x4 v0 = acc[ai][bj][m][0], v1 = acc[ai][bj][m][1];
                    u32x4 w; w.x = pk_bf16(v0[0] * h_lo(b.x), v0[1] * h_hi(b.x)); w.y = pk_bf16(v0[2] * h_lo(b.y), v0[3] * h_hi(b.y));
                    w.z = pk_bf16(v1[0] * h_lo(b.z), v1[1] * h_hi(b.z)); w.w = pk_bf16(v1[2] * h_lo(b.w), v1[3] * h_hi(b.w));
                    *(u32x4*)(MG + off + bj * 128) = w; }
                asm volatile("" ::: "memory"); }
    }
};

struct Epi3 {
    static constexpr int MID_T = 0;
    const float* base; float* out;
    __device__ __forceinline__ void mid(f32x4 (&)[2][2][4][2], const Unit&, int, int, int, int) const {}
    __device__ __forceinline__ void operator()(const f32x4 (&acc)[2][2][4][2], const Unit& u, int wr, int wc, int fr, int fq) const {
        const int rowb = u.r0 + wr * 64 + fr, colb = u.c0 + wc * 32 + 8 * fq;
#pragma unroll
        for (int ai = 0; ai < 2; ++ai)
#pragma unroll
            for (int m = 0; m < 4; ++m) { const size_t off = (size_t)(rowb + ai * 128 + m * 16) * D + colb;
#pragma unroll
                for (int bj = 0; bj < 2; ++bj) { const f32x4 b0 = *(const f32x4*)(base + off + bj * 128), b1 = *(const f32x4*)(base + off + bj * 128 + 4);
                    *(f32x4*)(out + off + bj * 128) = b0 + acc[ai][bj][m][0]; *(f32x4*)(out + off + bj * 128 + 4) = b1 + acc[ai][bj][m][1]; }
                asm volatile("" ::: "memory"); }
    }
};

struct Epi4 {
    static constexpr int MID_T = 0;
    bf16_t* ACT;
    __device__ __forceinline__ void mid(f32x4 (&)[2][2][4][2], const Unit&, int, int, int, int) const {}
    __device__ __forceinline__ void operator()(const f32x4 (&acc)[2][2][4][2], const Unit& u, int wr, int wc, int fr, int fq) const {
        const int rowb = u.r0 + wr * 64 + fr, colb = u.c0 + wc * 32 + 8 * fq;
#pragma unroll
        for (int ai = 0; ai < 2; ++ai)
#pragma unroll
            for (int m = 0; m < 4; ++m) { const f32x4 g0 = acc[ai][0][m][0], g1 = acc[ai][0][m][1], u0 = acc[ai][1][m][0], u1 = acc[ai][1][m][1]; f32x4 v0, v1;
#pragma unroll
                for (int e = 0; e < 4; ++e) { v0[e] = g0[e] * sigmoidf_(g0[e]) * u0[e]; v1[e] = g1[e] * sigmoidf_(g1[e]) * u1[e]; }
                u32x4 w; w.x = pk_bf16(v0[0], v0[1]); w.y = pk_bf16(v0[2], v0[3]); w.z = pk_bf16(v1[0], v1[1]); w.w = pk_bf16(v1[2], v1[3]);
                *(u32x4*)(ACT + (size_t)(rowb + ai * 128 + m * 16) * DFF + colb) = w; }
    }
};

struct Sched1 {
    const bf16_t* XN; const bf16_t* WT; int G, c;
    __device__ __forceinline__ bool next(int i, Unit& u) const {
        const int L = i * G + c; if (L >= 1152) return false;
        const int x = L & 7, off = L >> 3;
        if (off < 112) { const int pm = 8 * x + (off & 7), t = off >> 3;
            const int wt = t < 4 ? t : (t < 6 ? t + 2 : t + 4);
            u.A = (const char*)(XN + (size_t)pm * 256 * D); u.B = (const char*)(WT + (size_t)wt * 256 * D); u.r0 = pm * 256;
            if (t < 2) { u.kind = K_Q; u.c0 = t * 256; } else if (t < 4) { u.kind = K_K; u.c0 = (t - 2) * 256; } else if (t < 6) { u.kind = K_U; u.c0 = (t - 4) * 256; }
            else if (t < 10) { u.kind = K_G0; u.c0 = (t - 6) * 256; } else { u.kind = K_G1; u.c0 = (t - 10) * 256; }
        } else { const int o2 = off - 112, pn = 8 * x + (o2 & 7), w = o2 >> 3;
            const int wt = w < 2 ? 4 + w : 6 + w;
            u.A = (const char*)(WT + (size_t)wt * 256 * D); u.B = (const char*)(XN + (size_t)pn * 256 * D);
            u.kind = w < 2 ? K_VT : K_VGT; u.r0 = (w & 1) * 256; u.c0 = pn * 256; }
        return true;
    }
};
struct SchedN {
    const bf16_t* A; const bf16_t* Bt; int K, nN, cw, G, c;
    __device__ __forceinline__ bool next(int i, Unit& u) const {
        const int L = i * G + c; if (L >= 64 * nN) return false;
        const int x = L & 7, off = L >> 3, pm = 8 * x + (off & 7), pn = off >> 3;
        u.A = (const char*)(A + (size_t)pm * 256 * K); u.B = (const char*)(Bt + (size_t)pn * 256 * K); u.kind = 0; u.r0 = pm * 256; u.c0 = pn * cw; return true;
    }
};

#define XB_TMO      128
#define XB_XCNT(j)  (256  + 64 * (j))
#define XB_XSUB(j)  (1280 + 64 * (j))
#define XB_XGEN(j)  (2304 + 64 * (j))
#define XB_TOP      3328
#define XB_TOPGEN   3392
#define XCD_BAR_WORDS 3456
#define XB_SPIN_CAP (1u << 18)
__device__ __forceinline__ unsigned xb_ld(unsigned* p)              { return __hip_atomic_load(p, __ATOMIC_RELAXED, __HIP_MEMORY_SCOPE_AGENT); }
__device__ __forceinline__ unsigned xb_add(unsigned* p, unsigned v) { return __hip_atomic_fetch_add(p, v, __ATOMIC_RELAXED, __HIP_MEMORY_SCOPE_AGENT); }
__device__ __forceinline__ unsigned xb_xcc_id() { return (unsigned)__builtin_amdgcn_s_getreg((3 << 11) | 20) & 0xFu; }
#define XB_SPIN(cond, bar) do { unsigned _sp = 0; while (cond) { __builtin_amdgcn_s_sleep(1); \
    if ((++_sp & 255u) == 0u) { if (xb_ld(&(bar)[XB_TMO])) break; if (_sp > XB_SPIN_CAP) { atomicAdd(&(bar)[XB_TMO], 1u); break; } } } } while (0)
struct XcdBarrier { unsigned* bar; unsigned x; volatile LAS unsigned* st; };
__device__ __forceinline__ XcdBarrier xcd_barrier_post(unsigned* bar, volatile LAS unsigned* st) {
    XcdBarrier b; b.bar = bar; b.x = xb_xcc_id(); b.st = st;
    if (threadIdx.x == 0) (void)xb_add(&bar[XB_XCNT(b.x)], 1u);
    return b;
}
__device__ __forceinline__ void xcd_barrier_complete(unsigned* bar, unsigned x, unsigned& nloc, unsigned& nx) {
    const unsigned G = gridDim.x * gridDim.y * gridDim.z;
    unsigned sum, cnt, mine, sp = 0u;
    for (;;) {
        sum = 0u; cnt = 0u; mine = 0u;
#pragma unroll
        for (unsigned j = 0; j < 16; ++j) { const unsigned c = xb_ld(&bar[XB_XCNT(j)]); sum += c; cnt += (c > 0u) ? 1u : 0u; mine = (j == x) ? c : mine; }
        if (sum == G) break;
        __builtin_amdgcn_s_sleep(1);
        if ((++sp & 255u) == 0u) { if (xb_ld(&bar[XB_TMO])) break; if (sp > XB_SPIN_CAP) { atomicAdd(&bar[XB_TMO], 1u); break; } }
    }
    nloc = mine > 0u ? mine : 1u; nx = cnt > 0u ? cnt : 1u;
}
__device__ __forceinline__ void xcd_barrier(const XcdBarrier& b) {
    asm volatile("s_waitcnt vmcnt(0)" ::: "memory");
    __syncthreads();
    if (threadIdx.x == 0) {
        unsigned* bar = b.bar;
        __builtin_amdgcn_s_waitcnt(0);
        unsigned nloc = b.st[0], nx = b.st[1];
        if (nloc == 0u) { xcd_barrier_complete(bar, b.x, nloc, nx); b.st[0] = nloc; b.st[1] = nx; }
        const unsigned old = xb_add(&bar[XB_XSUB(b.x)], 1u);
        const unsigned gen = old / nloc;
        if (old + 1u == (gen + 1u) * nloc) {
            __builtin_amdgcn_fence(__ATOMIC_RELEASE, "agent");
            asm volatile("s_waitcnt vmcnt(0)" ::: "memory");
            const unsigned og = xb_add(&bar[XB_TOP], 1u);
            const unsigned tg = og / nx;
            if (og + 1u == (tg + 1u) * nx) xb_add(&bar[XB_TOPGEN], 1u);
            else XB_SPIN(xb_ld(&bar[XB_TOPGEN]) == tg, bar);
            __builtin_amdgcn_fence(__ATOMIC_ACQUIRE, "agent");
            xb_add(&bar[XB_XGEN(b.x)], 1u);
            asm volatile("s_waitcnt vmcnt(0)" ::: "memory");
        } else {
            XB_SPIN(xb_ld(&bar[XB_XGEN(b.x)]) == gen, bar);
            __builtin_amdgcn_fence(__ATOMIC_ACQUIRE, "agent");
            asm volatile("s_waitcnt vmcnt(0)" ::: "memory");
        }
    }
    __syncthreads();
}

struct Args { const float* in[16]; float* out; unsigned char* ws; int ph_lo, ph_hi; };

__device__ __forceinline__ void transpose_item(const float* W, int N, bf16_t* WT, int ldk, int koff, int k0, int n0, int drow0, LAS float* scr, int lane) {
#pragma unroll 8
    for (int i = 0; i < 32; ++i) { const int kk = 2 * i + (lane >> 5); scr[kk * 33 + (lane & 31)] = W[(size_t)(k0 + kk) * N + n0 + (lane & 31)]; }
    asm volatile("s_waitcnt lgkmcnt(0)" ::: "memory");
    const int c = lane & 7;
#pragma unroll
    for (int j = 0; j < 4; ++j) { const int n = (lane >> 3) + 8 * j; const LAS float* s = scr + (8 * c) * 33 + n;
        u32x4 o; o.x = pk_bf16(s[0 * 33], s[1 * 33]); o.y = pk_bf16(s[2 * 33], s[3 * 33]); o.z = pk_bf16(s[4 * 33], s[5 * 33]); o.w = pk_bf16(s[6 * 33], s[7 * 33]);
        *(u32x4*)(WT + (size_t)(drow0 + n) * ldk + koff + k0 + 8 * c) = o; }
    asm volatile("s_waitcnt lgkmcnt(0)" ::: "memory");
}
__device__ __forceinline__ void rms_row_bf16(const float* xrow, const float* g, bf16_t* orow, int lane) {
    const f32x4* xr = (const f32x4*)xrow + lane; const f32x4* gr = (const f32x4*)g + lane;
    f32x4 v[4]; float s = 0.f;
#pragma unroll
    for (int j = 0; j < 4; ++j) { v[j] = xr[64 * j]; s += (v[j].x * v[j].x + v[j].y * v[j].y) + (v[j].z * v[j].z + v[j].w * v[j].w); }
    const float r = 1.0f / sqrtf(wave_sum(s) * (1.f / D) + EPS);
    u32x2* o8 = (u32x2*)orow + lane;
#pragma unroll
    for (int j = 0; j < 4; ++j) { const f32x4 q = gr[64 * j]; u32x2 w; w.x = pk_bf16(v[j].x * r * q.x, v[j].y * r * q.y); w.y = pk_bf16(v[j].z * r * q.z, v[j].w * r * q.w); o8[64 * j] = w; }
}
__device__ __forceinline__ void rms_row_f32(const float* xrow, const float* g, float* orow, int lane) {
    const f32x4* xr = (const f32x4*)xrow + lane; const f32x4* gr = (const f32x4*)g + lane;
    f32x4 v[4]; float s = 0.f;
#pragma unroll
    for (int j = 0; j < 4; ++j) { v[j] = xr[64 * j]; s += (v[j].x * v[j].x + v[j].y * v[j].y) + (v[j].z * v[j].z + v[j].w * v[j].w); }
    const float r = 1.0f / sqrtf(wave_sum(s) * (1.f / D) + EPS);
    f32x4* o = (f32x4*)orow + lane;
#pragma unroll
    for (int j = 0; j < 4; ++j) { const f32x4 q = gr[64 * j]; o[64 * j] = v[j] * r * q; }
}

__device__ __forceinline__ void attn_unit(int b, int c, const bf16_t* Q, const bf16_t* Kb, const bf16_t* VT, bf16_t* AS, const float* relb, LAS float* tab, LAS unsigned char* qlds, int wid, int lane) {
    const int r32 = lane & 31, hi = lane >> 5;
    for (int i = lane; i < 257; i += 64) tab[i] = relb[wid * 257 + i] * LOG2E;
    const float c256 = relb[wid * 257 + 256] * LOG2E;
    const int t0 = b * SEQ + 64 * c;
#pragma unroll
    for (int qb = 0; qb < 2; ++qb)
#pragma unroll
        for (int d0 = 0; d0 < 4; ++d0) *(LAS bf16x8*)(qlds + (qb * 4 + d0) * 1024 + lane * 16) = *(const bf16x8*)(Q + (size_t)(t0 + 32 * qb + r32) * 512 + 64 * wid + 16 * d0 + 8 * hi);
    f32x16 o[2][2];
#pragma unroll
    for (int db = 0; db < 2; ++db)
#pragma unroll
        for (int qb = 0; qb < 2; ++qb)
#pragma unroll
            for (int r = 0; r < 16; ++r) o[db][qb][r] = 0.f;
    float mrun[2] = {-1e30f, -1e30f}, lrun[2] = {0.f, 0.f};
    const int kt0 = c >= 8 ? 0 : 8 - c;
    for (int kt = kt0; kt < 9; ++kt) {
        const int kbase = t0 - 512 + 64 * kt;
        bf16x8 kf[2][4];
#pragma unroll
        for (int kh = 0; kh < 2; ++kh)
#pragma unroll
            for (int d0 = 0; d0 < 4; ++d0) kf[kh][d0] = *(const bf16x8*)(Kb + (size_t)(kbase + 32 * kh + r32) * 512 + 64 * wid + 16 * d0 + 8 * hi);
        u32x4 pk[2][2][2];
        LAS unsigned char* qp = qlds + lane * 16; asm volatile("" : "+v"(qp));
#pragma unroll
        for (int qb = 0; qb < 2; ++qb) {
            f32x16 p0, p1;
            if (kt < 6) {
#pragma unroll
                for (int r = 0; r < 16; ++r) { p0[r] = c256; p1[r] = c256; }
            } else {
                const int base = 640 + 32 * qb + r32 - 64 * kt - 4 * hi;
#pragma unroll
                for (int r = 0; r < 16; ++r) { const int i0 = base - ((r & 3) + 8 * (r >> 2)); p0[r] = tab[i0 > 256 ? 256 : i0]; const int i1 = i0 - 32; p1[r] = tab[i1 > 256 ? 256 : i1]; }
            }
#pragma unroll
            for (int d0 = 0; d0 < 4; ++d0) { const bf16x8 qfr = *(const LAS bf16x8*)(qp + (qb * 4 + d0) * 1024);
                p0 = __builtin_amdgcn_mfma_f32_32x32x16_bf16(kf[0][d0], qfr, p0, 0, 0, 0); p1 = __builtin_amdgcn_mfma_f32_32x32x16_bf16(kf[1][d0], qfr, p1, 0, 0, 0); }
            float mx = fmaxf(p0[0], p1[0]);
#pragma unroll
            for (int r = 1; r < 16; ++r) mx = fmaxf(mx, fmaxf(p0[r], p1[r]));
            mx = fmaxf(mx, __shfl_xor(mx, 32));
            const float mnew = fmaxf(mrun[qb], mx), alpha = fexp2(mrun[qb] - mnew); mrun[qb] = mnew;
            float rs = 0.f;
#pragma unroll
            for (int r = 0; r < 16; ++r) { p0[r] = fexp2(p0[r] - mnew); p1[r] = fexp2(p1[r] - mnew); rs += p0[r] + p1[r]; }
            lrun[qb] = lrun[qb] * alpha + rs;
#pragma unroll
            for (int r = 0; r < 16; ++r) { o[0][qb][r] *= alpha; o[1][qb][r] *= alpha; }
#pragma unroll
            for (int s = 0; s < 2; ++s) {
                pk[qb][0][s] = (u32x4){pk_bf16(p0[8 * s], p0[8 * s + 1]), pk_bf16(p0[8 * s + 2], p0[8 * s + 3]), pk_bf16(p0[8 * s + 4], p0[8 * s + 5]), pk_bf16(p0[8 * s + 6], p0[8 * s + 7])};
                pk[qb][1][s] = (u32x4){pk_bf16(p1[8 * s], p1[8 * s + 1]), pk_bf16(p1[8 * s + 2], p1[8 * s + 3]), pk_bf16(p1[8 * s + 4], p1[8 * s + 5]), pk_bf16(p1[8 * s + 6], p1[8 * s + 7])};
            }
        }
#pragma unroll
        for (int db = 0; db < 2; ++db) {
            bf16x8 vf[2][2];
#pragma unroll
            for (int kh = 0; kh < 2; ++kh)
#pragma unroll
                for (int s = 0; s < 2; ++s) vf[kh][s] = *(const bf16x8*)(VT + (size_t)(64 * wid + 32 * db + r32) * M + kbase + 32 * kh + 16 * s + 8 * hi);
#pragma unroll
            for (int qb = 0; qb < 2; ++qb)
#pragma unroll
                for (int kh = 0; kh < 2; ++kh)
#pragma unroll
                    for (int s = 0; s < 2; ++s) o[db][qb] = __builtin_amdgcn_mfma_f32_32x32x16_bf16(vf[kh][s], __builtin_bit_cast(bf16x8, pk[qb][kh][s]), o[db][qb], 0, 0, 0);
        }
    }
#pragma unroll
    for (int qb = 0; qb < 2; ++qb) {
        const float l = lrun[qb] + __shfl_xor(lrun[qb], 32), inv = 1.0f / l;
        bf16_t* orow = AS + (size_t)(t0 + 32 * qb + r32) * D + 64 * wid + 4 * hi;
#pragma unroll
        for (int db = 0; db < 2; ++db)
#pragma unroll
            for (int g4 = 0; g4 < 4; ++g4) { u32x2 w; w.x = pk_bf16(o[db][qb][4 * g4] * inv, o[db][qb][4 * g4 + 1] * inv); w.y = pk_bf16(o[db][qb][4 * g4 + 2] * inv, o[db][qb][4 * g4 + 3] * inv);
                *(u32x2*)(orow + 32 * db + 8 * g4) = w; }
    }
}

__device__ __forceinline__ void sgu_unit(int n, int g, const bf16_t* VGT, const bf16_t* UG, const f32x2* stats, const bf16_t* SGWb, const float* R2, const float* bs, const float* lng, const float* lnb,
                                         bf16_t* AS, LAS f32x2* st, int tid, int wid, int lane) {
    const int r32 = lane & 31, hi = lane >> 5, tok0 = 128 * n;
    __syncthreads();
    if (tid < 128) { const f32x2* sp = stats + (size_t)(tok0 + tid) * 4; const f32x2 a = sp[0], b = sp[1], c = sp[2], d = sp[3];
        const float S = (a.x + b.x) + (c.x + d.x), Q2 = (a.y + b.y) + (c.y + d.y), mu = S * (1.f / SW), var = fmaxf(Q2 * (1.f / SW) - mu * mu, 0.f);
        st[tid] = (f32x2){mu, 1.0f / sqrtf(var + EPS)}; }
    __syncthreads();
    const int cb = wid >> 1;
    const bf16_t* vrow = VGT + (size_t)(128 * g + 32 * cb + r32) * M + tok0 + 8 * hi;
    for (int tbi = 0; tbi < 2; ++tbi) {
        const int tb = 2 * (wid & 1) + tbi;
        f32x16 acc;
#pragma unroll
        for (int r = 0; r < 16; ++r) acc[r] = 0.f;
        const bf16_t* wrow = SGWb + (size_t)(g * 128 + 32 * tb + r32) * 128 + 8 * hi;
        const int nsteps = 2 * (tb + 1);
        for (int s = 0; s < nsteps; ++s) {
            const u32x4 raw = *(const u32x4*)(vrow + 16 * s);
            const LAS f32x4* sp = (const LAS f32x4*)(st + 16 * s + 8 * hi);
            const f32x4 m01 = sp[0], m23 = sp[1], m45 = sp[2], m67 = sp[3];
            u32x4 a;
            a.x = pk_bf16((bf_lo(raw.x) - m01[0]) * m01[1], (bf_hi(raw.x) - m01[2]) * m01[3]);
            a.y = pk_bf16((bf_lo(raw.y) - m23[0]) * m23[1], (bf_hi(raw.y) - m23[2]) * m23[3]);
            a.z = pk_bf16((bf_lo(raw.z) - m45[0]) * m45[1], (bf_hi(raw.z) - m45[2]) * m45[3]);
            a.w = pk_bf16((bf_lo(raw.w) - m67[0]) * m67[1], (bf_hi(raw.w) - m67[2]) * m67[3]);
            const bf16x8 wf = *(const bf16x8*)(wrow + 16 * s);
            acc = __builtin_amdgcn_mfma_f32_32x32x16_bf16(__builtin_bit_cast(bf16x8, a), wf, acc, 0, 0, 0);
        }
        const int t = 32 * tb + r32;
        const float r2t = R2[g * 128 + t], bst = bs[g * 128 + t];
        const size_t tok = (size_t)(tok0 + t);
#pragma unroll
        for (int q4 = 0; q4 < 4; ++q4) { const int ch = 128 * g + 32 * cb + 8 * q4 + 4 * hi;
            const f32x4 lg = *(const f32x4*)(lng + ch), lb = *(const f32x4*)(lnb + ch);
            const u32x2 ug = *(const u32x2*)(UG + tok * 512 + ch);
            const float v0 = bf_lo(ug.x) * (lg[0] * acc[4 * q4] + lb[0] * r2t + bst), v1 = bf_hi(ug.x) * (lg[1] * acc[4 * q4 + 1] + lb[1] * r2t + bst);
            const float v2 = bf_lo(ug.y) * (lg[2] * acc[4 * q4 + 2] + lb[2] * r2t + bst), v3 = bf_hi(ug.y) * (lg[3] * acc[4 * q4 + 3] + lb[3] * r2t + bst);
            u32x2 w; w.x = pk_bf16(v0, v1); w.y = pk_bf16(v2, v3);
            *(u32x2*)(AS + tok * D + 512 + ch) = w; }
    }
}

constexpr int LDS_BYTES = 147456;
constexpr int MISC_OFF = 131072 + 320;

__global__ void __launch_bounds__(NTHREADS, 2) mega_fwd(Args args) {
    extern __shared__ __attribute__((aligned(16))) unsigned char lds_raw[];
    LAS unsigned char* lds = (LAS unsigned char*)lds_raw;
    volatile LAS unsigned* MISC = (volatile LAS unsigned*)(lds + MISC_OFF);
    const int tid = threadIdx.x, lane = tid & 63, wid = __builtin_amdgcn_readfirstlane(tid >> 6);
    const int G = gridDim.x, bx = blockIdx.x;
    const int vcu = (G % 8 == 0) ? (bx % 8) * (G / 8) + bx / 8 : bx;
    unsigned char* ws = args.ws;
    unsigned* ctl = (unsigned*)(ws + WS_CTL);
    for (int u = tid; u < (LDS_BYTES - 131072) / 4; u += NTHREADS) ((LAS unsigned*)(lds + 131072))[u] = 0u;
    __syncthreads();
    XcdBarrier bar; bar.bar = ctl + CW_BAR; bar.x = 0; bar.st = nullptr;
    if (MK_LAUNCHES == 1) bar = xcd_barrier_post(ctl + CW_BAR, MISC + 8);
    const int lo = args.ph_lo, hi_ = args.ph_hi;
#ifndef PH_MASK
#define PH_MASK 0x1ff
#endif
#define IN(k) (lo <= (k) && (k) < hi_)
#define PHON(j) ((PH_MASK >> (j)) & 1)
#define SEAM(k) do { if (MK_LAUNCHES == 1 && IN((k) + 1)) xcd_barrier(bar); } while (0)

    const float* x = args.in[0]; float* H = args.out;
#define P_XN   ((bf16_t*)(ws + WS_XN))
#define P_Q    ((bf16_t*)(ws + WS_Q))
#define P_K    ((bf16_t*)(ws + WS_K))
#define P_VT   ((bf16_t*)(ws + WS_VT))
#define P_UG   ((bf16_t*)(ws + WS_UG))
#define P_VGT  ((bf16_t*)(ws + WS_VGT))
#define P_G0   ((unsigned short*)(ws + WS_G0))
#define P_G1   ((unsigned short*)(ws + WS_G1))
#define P_MG   ((bf16_t*)(ws + WS_MG))
#define P_ACT  ((bf16_t*)(ws + WS_ACT))
#define P_STATS ((f32x2*)(ws + WS_STATS))
#define P_SGWB ((bf16_t*)(ws + WS_SGWB))
#define P_R2   ((float*)(ws + WS_R2))
    const int gw = vcu * NWAVES + wid, NGW = G * NWAVES;

    if (PHON(0) && IN(0)) {
        LAS float* scr = (LAS float*)(lds + wid * 16384);
        constexpr int I_IN = 16 * 144, I_BA = 8 * 32, I_BS = 8 * 32, I_OUT = 16 * 32, I_FI = 16 * 176, I_FO = 44 * 32, I_LAYER = I_IN + I_BA + I_BS + I_OUT + I_FI + I_FO;
        for (int it = gw; it < DEPTH * I_LAYER; it += NGW) {
            const int l = it / I_LAYER; int r = it % I_LAYER;
            unsigned char* wl = ws + WS_W + (size_t)l * W_LAYER;
            if (r < I_IN) { const int kb = r / 144, nb = r % 144; transpose_item(args.in[2] + (size_t)l * D * INW, INW, (bf16_t*)(wl + W_IN), D, 0, 64 * kb, 32 * nb, 32 * nb, scr, lane); continue; } r -= I_IN;
            if (r < I_BA) { const int kb = r / 32, nb = r % 32; transpose_item(args.in[8] + (size_t)l * AW * D, D, (bf16_t*)(wl + W_BR), D, 0, 64 * kb, 32 * nb, 32 * nb, scr, lane); continue; } r -= I_BA;
            if (r < I_BS) { const int kb = r / 32, nb = r % 32; transpose_item(args.in[9] + (size_t)l * SW * D, D, (bf16_t*)(wl + W_BR), D, 512, 64 * kb, 32 * nb, 32 * nb, scr, lane); continue; } r -= I_BS;
            if (r < I_OUT) { const int kb = r / 32, nb = r % 32; transpose_item(args.in[11] + (size_t)l * D * D, D, (bf16_t*)(wl + W_OUT), D, 0, 64 * kb, 32 * nb, 32 * nb, scr, lane); continue; } r -= I_OUT;
            if (r < I_FI) { const int kb = r / 176, nb = r % 176, n0 = 32 * nb;
                const int nn = n0 < DFF ? n0 : n0 - DFF, drow = 256 * (nn / 128) + (nn % 128) + (n0 < DFF ? 0 : 128);
                transpose_item(args.in[13] + (size_t)l * D * 2 * DFF, 2 * DFF, (bf16_t*)(wl + W_FI), D, 0, 64 * kb, n0, drow, scr, lane); continue; } r -= I_FI;
            { const int kb = r / 32, nb = r % 32; transpose_item(args.in[14] + (size_t)l * DFF * D, D, (bf16_t*)(wl + W_FO), DFF, 0, 64 * kb, 32 * nb, 32 * nb, scr, lane); }
        }
        for (int row = gw; row < DEPTH * 4 * 128; row += NGW) { const int t = row & 127; const float* wr_ = args.in[6] + (size_t)row * 128;
            const float a = (lane <= t) ? wr_[lane] : 0.f, b = (lane + 64 <= t) ? wr_[lane + 64] : 0.f;
            P_SGWB[(size_t)row * 128 + lane] = (bf16_t)(pk_bf16(a, 0.f) & 0xffffu); P_SGWB[(size_t)row * 128 + lane + 64] = (bf16_t)(pk_bf16(b, 0.f) & 0xffffu);
            const float s = wave_sum(a + b); if (lane == 0) P_R2[row] = s; }
        for (int m = gw; m < M; m += NGW) rms_row_bf16(x + (size_t)m * D, args.in[1], P_XN + (size_t)m * D, lane);
        SEAM(0);
    }
    for (int l = 0; l < DEPTH; ++l) {
        const int pb = 1 + 8 * l;
        unsigned char* wl = ws + WS_W + (size_t)l * W_LAYER;
        if (PHON(1) && IN(pb + 0)) {
            Sched1 S{P_XN, (const bf16_t*)(wl + W_IN), G, bx};
            Epi1 E{P_Q, P_K, P_VT, P_UG, P_VGT, P_G0, P_G1, args.in[10] + (size_t)l * 2 * D, P_STATS};
            pg8::gemm_phase<Epi1, Sched1>(lds, D, S, E);
            SEAM(pb + 0);
        }
        if (PHON(2) && IN(pb + 1)) {
            int tid = threadIdx.x; asm volatile("" : "+v"(tid));
            const int lane = tid & 63, wid = __builtin_amdgcn_readfirstlane(tid >> 6);
            for (int uu = vcu; uu < 256; uu += G) attn_unit(uu >> 6, uu & 63, P_Q, P_K, P_VT, P_XN, args.in[3] + (size_t)l * NH * 257, (LAS float*)(lds + wid * 2048), lds + 65536 + wid * 8192, wid, lane);
            for (int uu = vcu; uu < 512; uu += G) sgu_unit(uu >> 2, uu & 3, P_VGT, P_UG, P_STATS, P_SGWB + (size_t)l * 4 * 128 * 128, P_R2 + l * 512, args.in[7] + l * 512, args.in[4] + l * SW, args.in[5] + l * SW,
                                                           P_XN, (LAS f32x2*)(lds + 32768), tid, wid, lane);
            SEAM(pb + 1);
        }
        if (PHON(3) && IN(pb + 2)) {
            SchedN S{P_XN, (const bf16_t*)(wl + W_BR), D, 4, 256, G, bx};
            Epi2 E{P_G0, P_G1, P_MG};
            pg8::gemm_phase<Epi2, SchedN>(lds, D, S, E);
            SEAM(pb + 2);
        }
        if (PHON(4) && IN(pb + 3)) {
            SchedN S{P_MG, (const bf16_t*)(wl + W_OUT), D, 4, 256, G, bx};
            Epi3 E{l == 0 ? x : (const float*)H, H};
            pg8::gemm_phase<Epi3, SchedN>(lds, D, S, E);
            SEAM(pb + 3);
        }
        if (PHON(5) && IN(pb + 4)) {
            int lane = threadIdx.x & 63; asm volatile("" : "+v"(lane));
            for (int m = gw; m < M; m += NGW) rms_row_bf16(H + (size_t)m * D, args.in[12] + l * D, P_XN + (size_t)m * D, lane);
            SEAM(pb + 4);
        }
        if (PHON(6) && IN(pb + 5)) {
            SchedN S{P_XN, (const bf16_t*)(wl + W_FI), D, 22, 128, G, bx};
            Epi4 E{P_ACT};
            pg8::gemm_phase<Epi4, SchedN>(lds, D, S, E);
            SEAM(pb + 5);
        }
        if (PHON(7) && IN(pb + 6)) {
            SchedN S{P_ACT, (const bf16_t*)(wl + W_FO), DFF, 4, 256, G, bx};
            Epi3 E{H, H};
            pg8::gemm_phase<Epi3, SchedN>(lds, DFF, S, E);
            SEAM(pb + 6);
        }
        if (PHON(8) && IN(pb + 7)) {
            int lane = threadIdx.x & 63; asm volatile("" : "+v"(lane));
            if (l + 1 < DEPTH) { for (int m = gw; m < M; m += NGW) rms_row_bf16(H + (size_t)m * D, args.in[1] + (l + 1) * D, P_XN + (size_t)m * D, lane); SEAM(pb + 7); }
            else { for (int m = gw; m < M; m += NGW) rms_row_f32(H + (size_t)m * D, args.in[15], H + (size_t)m * D, lane); }
        }
    }
#undef IN
#undef SEAM
}

extern "C" void kernel_launch(void* const* d_in, const int* in_sizes, int n_in, void* d_out, int out_size, void* d_ws, size_t ws_size, hipStream_t stream) {
    static int grid = 0;
    if (grid == 0) {
        if (n_in != 16 || out_size != M * D || ws_size < WS_END) { fprintf(stderr, "kernel_launch: unexpected shapes (n_in %d, out %d, ws %zu)\n", n_in, out_size, ws_size); grid = -1; return; }
        int dev = 0, cus = 0, per_cu = 0;
        if (hipGetDevice(&dev) != hipSuccess || hipDeviceGetAttribute(&cus, hipDeviceAttributeMultiprocessorCount, dev) != hipSuccess) { grid = -1; return; }
        if (hipFuncSetAttribute((const void*)mega_fwd, hipFuncAttributeMaxDynamicSharedMemorySize, LDS_BYTES) != hipSuccess) { fprintf(stderr, "kernel_launch: hipFuncSetAttribute failed\n"); grid = -1; return; }
        if (hipOccupancyMaxActiveBlocksPerMultiprocessor(&per_cu, (const void*)mega_fwd, NTHREADS, LDS_BYTES) != hipSuccess || per_cu < 1) { fprintf(stderr, "kernel_launch: occupancy query says %d blocks per CU\n", per_cu); (void)hipGetLastError(); grid = -1; return; }
        grid = cus;
    }
    if (grid < 0) return;
    (void)hipMemsetAsync((char*)d_ws + WS_CTL, 0, CTL_ZERO_BYTES, stream);
    Args a{};
    for (int i = 0; i < 16; ++i) a.in[i] = (const float*)d_in[i];
    a.out = (float*)d_out; a.ws = (unsigned char*)d_ws;
    constexpr int NPH = 1 + 8 * DEPTH;
    if (MK_LAUNCHES == 1) { a.ph_lo = 0; a.ph_hi = NPH; hipLaunchKernelGGL(mega_fwd, dim3(grid), dim3(NTHREADS), LDS_BYTES, stream, a); }
    else for (int p = 0; p < NPH; ++p) { a.ph_lo = p; a.ph_hi = p + 1; hipLaunchKernelGGL(mega_fwd, dim3(grid), dim3(NTHREADS), LDS_BYTES, stream, a); }
}
```

```cpp
#include <hip/hip_runtime.h>
#include <cstdio>
#include <cstdint>

#ifndef MK_LAUNCHES
#define MK_LAUNCHES 1
#endif

#ifndef PROBE_REP
#define PROBE_REP (-1)
#endif
#ifndef PROBE_SUB
#define PROBE_SUB 0
#endif
#ifndef PROBE_BARS
#define PROBE_BARS 0
#endif

#define LAS __attribute__((address_space(3)))
#define GAS __attribute__((address_space(1)))
typedef unsigned short bf16_t;
typedef short bf16x8 __attribute__((ext_vector_type(8)));
typedef short s16x4 __attribute__((ext_vector_type(4)));
typedef float f32x2 __attribute__((ext_vector_type(2)));
typedef float f32x4 __attribute__((ext_vector_type(4)));
typedef float f32x16 __attribute__((ext_vector_type(16)));
typedef unsigned u32x2 __attribute__((ext_vector_type(2)));
typedef unsigned u32x4 __attribute__((ext_vector_type(4)));
typedef __bf16 bf16x2_t __attribute__((ext_vector_type(2)));
typedef _Float16 f16x2_t __attribute__((ext_vector_type(2)));

constexpr int M = 16384, D = 1024, SEQ = 4096, NBATCH = 4, DEPTH = 2;
constexpr int AW = 512, SW = 512, INW = 4608, DFF = 2816, NH = 8;
constexpr float EPS = 1e-6f;
constexpr float LOG2E = 1.4426950408889634f;
constexpr float QSCALE = 0.125f * LOG2E;
constexpr int NWAVES = 8, NTHREADS = 512;
constexpr int KP = 576;

constexpr size_t MiB = 1u << 20;
constexpr size_t WS_CTL = 0, CTL_ZERO_BYTES = 64 * 1024;
constexpr size_t WS_STATS = 1 * MiB;
constexpr size_t WS_SGWB = 1 * MiB + 512 * 1024;
constexpr size_t WS_R2 = 1 * MiB + 768 * 1024;
constexpr size_t WS_W = 2 * MiB, W_LAYER = 30 * MiB;
constexpr size_t W_IN = 0, W_BR = 9 * MiB, W_OUT = 11 * MiB, W_FI = 13 * MiB, W_FO = 24 * MiB;
constexpr size_t WS_XN = 64 * MiB;
constexpr size_t WS_Q = 96 * MiB, WS_K = 112 * MiB, WS_VT = 128 * MiB, WS_UG = 144 * MiB, WS_VGT = 162 * MiB, WS_G0 = 184 * MiB, WS_G1 = 216 * MiB;
constexpr size_t WS_MG = 96 * MiB;
constexpr size_t WS_ACT = 96 * MiB;
constexpr size_t WS_END = 248 * MiB;
constexpr int CW_BAR = 1024;

__device__ __forceinline__ unsigned pk_bf16(float lo, float hi) { f32x2 v = {lo, hi}; bf16x2_t b = __builtin_convertvector(v, bf16x2_t); return __builtin_bit_cast(unsigned, b); }
__device__ __forceinline__ unsigned pk_f16(float lo, float hi) { f32x2 v = {lo, hi}; f16x2_t b = __builtin_convertvector(v, f16x2_t); return __builtin_bit_cast(unsigned, b); }
__device__ __forceinline__ float bf_lo(unsigned w) { return __uint_as_float(w << 16); }
__device__ __forceinline__ float bf_hi(unsigned w) { return __uint_as_float(w & 0xffff0000u); }
__device__ __forceinline__ float h_lo(unsigned w) { f16x2_t h = __builtin_bit_cast(f16x2_t, w); return (float)h[0]; }
__device__ __forceinline__ float h_hi(unsigned w) { f16x2_t h = __builtin_bit_cast(f16x2_t, w); return (float)h[1]; }
__device__ __forceinline__ float fexp2(float x) { return __builtin_amdgcn_exp2f(x); }
__device__ __forceinline__ float frcp(float x) { return __builtin_amdgcn_rcpf(x); }
__device__ __forceinline__ float sigmoidf_(float z) { return frcp(1.f + fexp2(-LOG2E * z)); }
__device__ __forceinline__ float gelu_tanh(float x) { const float t = x * (1.f + 0.044715f * x * x) * (-2.302208198f); return x * frcp(1.f + fexp2(t)); }
__device__ __forceinline__ float wave_sum(float v) {
#pragma unroll
    for (int o = 1; o < 64; o <<= 1) v += __shfl_xor(v, o);
    return v;
}
__device__ __forceinline__ int crow(int r, int hi) { return (r & 3) + 8 * (r >> 2) + 4 * hi; }

namespace pg8 {
constexpr int BM = 256, BK = 64, HALF = 128, HTB = HALF * BK * 2, STAGE_BYTES = 8 * HTB;
__host__ __device__ __forceinline__ int lds_byte(int r, int c) { const int st = (r >> 4) * 2 + (c >> 5), rr = r & 15, cc = c & 31, ob = rr * 64 + cc * 2; return st * 1024 + (ob ^ (((ob >> 9) & 1) << 5)); }
__host__ __device__ __forceinline__ void stage_rc(int b, int& R, int& C) { const int st = b / 1024, sb = b % 1024, swz = sb ^ (((sb >> 9) & 1) << 5); R = (st >> 1) * 16 + swz / 64; C = (st & 1) * 32 + (swz % 64) / 2; }
__host__ __device__ __forceinline__ int perm32(int rho) { const int n = rho >> 4, i = rho & 15; return 8 * (i >> 2) + 4 * n + (i & 3); }

struct Unit { const char* A; const char* B; int kind, r0, c0; };

template <class Epi, class Sched>
__device__ __forceinline__ void gemm_phase(LAS unsigned char* lds, const int K, const Sched& S, const Epi& E) {
    int tid = threadIdx.x; asm volatile("" : "+v"(tid));
    const int wid = __builtin_amdgcn_readfirstlane(tid >> 6), lane = tid & 63, wr = wid >> 2, wc = wid & 3, fr = lane & 15, fq = lane >> 4;
    const int nt = K / BK;
    unsigned voffA[2], voffB[2];
#pragma unroll
    for (int i = 0; i < 2; ++i) { int R, C; stage_rc(tid * 16 + i * 8192, R, C); const int Rb = (R & ~31) + perm32(R & 31);
        voffA[i] = (unsigned)(R * K + C) * 2u; voffB[i] = (unsigned)(Rb * K + C) * 2u; }
    const size_t kstep = (size_t)(BK * 2);
    const size_t hstep = (size_t)HALF * K * 2;
    const unsigned ldsw = (unsigned)wid * 1024u;
    const int aoff = lds_byte(wr * 64 + fr, fq * 8), boff = lds_byte(wc * 32 + fr, fq * 8);
#define PG8_SA(b, h) (((b) * 2 + (h)) * HTB)
#define PG8_SB(b, h) ((4 + (b) * 2 + (h)) * HTB)
#define PG8_STAGE(bufoff, gbase, voff) do { _Pragma("unroll") for (int _i = 0; _i < 2; ++_i) \
        __builtin_amdgcn_global_load_lds((const unsigned*)((const char*)(gbase) + (voff)[_i]), (LAS unsigned*)(lds + (bufoff) + ldsw + _i * 8192), 16, 0, 0); } while (0)
#define PG8_LDA(dst, b, h) do { _Pragma("unroll") for (int m = 0; m < 4; ++m) _Pragma("unroll") for (int k = 0; k < 2; ++k) dst[m][k] = *(const LAS bf16x8*)(lds + PG8_SA(b, h) + aoff + m * 2048 + k * 1024); } while (0)
#define PG8_LDB(dst, b, h) do { _Pragma("unroll") for (int n = 0; n < 2; ++n) _Pragma("unroll") for (int k = 0; k < 2; ++k) dst[n][k] = *(const LAS bf16x8*)(lds + PG8_SB(b, h) + boff + n * 2048 + k * 1024); } while (0)
#define PG8_MMA(ai, bj, At, Bt) do { __builtin_amdgcn_s_setprio(1); _Pragma("unroll") for (int m = 0; m < 4; ++m) _Pragma("unroll") for (int n = 0; n < 2; ++n) _Pragma("unroll") for (int k = 0; k < 2; ++k) \
        acc[ai][bj][m][n] = __builtin_amdgcn_mfma_f32_16x16x32_bf16(Bt[n][k], At[m][k], acc[ai][bj][m][n], 0, 0, 0); __builtin_amdgcn_s_setprio(0); } while (0)
#define PG8_WAIT_V(n) asm volatile("s_waitcnt vmcnt(" #n ")" ::: "memory")
#define PG8_WAIT_L(n) asm volatile("s_waitcnt lgkmcnt(" #n ")" ::: "memory")
#define PG8_BAR __builtin_amdgcn_s_barrier()
#define PG8_SCHED __builtin_amdgcn_sched_barrier(0)
    Unit cur, nxt; int ui = 0;
    if (!S.next(0, cur)) return;
    f32x4 acc[2][2][4][2];
#pragma unroll
    for (int a = 0; a < 2; ++a)
#pragma unroll
        for (int b = 0; b < 2; ++b)
#pragma unroll
            for (int m = 0; m < 4; ++m)
#pragma unroll
                for (int n = 0; n < 2; ++n) acc[a][b][m][n] = (f32x4){0.f, 0.f, 0.f, 0.f};
    bf16x8 At[4][2], B0[2][2], B1[2][2];
    const char* cA = cur.A; const char* cB = cur.B;
    PG8_STAGE(PG8_SB(0, 0), cB, voffB); PG8_STAGE(PG8_SB(0, 1), cB + hstep, voffB); PG8_STAGE(PG8_SA(0, 0), cA, voffA); PG8_STAGE(PG8_SA(0, 1), cA + hstep, voffA);
    if (wr == 1) PG8_BAR;
    PG8_WAIT_V(2); PG8_BAR;
    PG8_STAGE(PG8_SB(1, 0), cB + kstep, voffB); PG8_STAGE(PG8_SA(1, 0), cA + kstep, voffA); PG8_STAGE(PG8_SB(1, 1), cB + hstep + kstep, voffB);
    PG8_WAIT_V(6); PG8_BAR;
    for (;;) {
        const bool has_next = S.next(ui + 1, nxt);
        const char* nA = has_next ? nxt.A : cA; const char* nB = has_next ? nxt.B : cB;
        for (int t = 0; t < nt; t += 2) {
            if (Epi::MID_T > 0 && t == Epi::MID_T) E.mid(acc, cur, wr, wc, fr, fq);
            const bool last = (t == nt - 2);
            const char* a1 = cA + (size_t)(t + 1) * kstep;
            const char* a2 = last ? nA : cA + (size_t)(t + 2) * kstep; const char* b2 = last ? nB : cB + (size_t)(t + 2) * kstep;
            const char* a3 = a2 + kstep; const char* b3 = b2 + kstep;
            PG8_LDB(B0, 0, 0); PG8_LDB(B1, 0, 1); PG8_SCHED; PG8_LDA(At, 0, 0); PG8_STAGE(PG8_SA(1, 1), a1 + hstep, voffA);
            PG8_WAIT_V(8); PG8_WAIT_L(0); PG8_BAR; PG8_MMA(0, 0, At, B0); PG8_MMA(0, 1, At, B1); PG8_BAR; PG8_SCHED;
            PG8_LDA(At, 0, 1); PG8_STAGE(PG8_SB(0, 0), b2, voffB); PG8_STAGE(PG8_SB(0, 1), b2 + hstep, voffB); PG8_STAGE(PG8_SA(0, 0), a2, voffA);
            PG8_WAIT_V(8); PG8_WAIT_L(0); PG8_BAR; PG8_MMA(1, 0, At, B0); PG8_MMA(1, 1, At, B1); PG8_BAR; PG8_SCHED;
            PG8_LDB(B0, 1, 0); PG8_LDB(B1, 1, 1); PG8_SCHED; PG8_LDA(At, 1, 0); PG8_STAGE(PG8_SA(0, 1), a2 + hstep, voffA);
            PG8_WAIT_V(8); PG8_WAIT_L(0); PG8_BAR; PG8_MMA(0, 0, At, B0); PG8_MMA(0, 1, At, B1); PG8_BAR; PG8_SCHED;
            PG8_LDA(At, 1, 1); PG8_STAGE(PG8_SB(1, 0), b3, voffB); PG8_STAGE(PG8_SB(1, 1), b3 + hstep, voffB); PG8_STAGE(PG8_SA(1, 0), a3, voffA);
            PG8_WAIT_V(8); PG8_WAIT_L(0); PG8_BAR; PG8_MMA(1, 0, At, B0); PG8_MMA(1, 1, At, B1); PG8_BAR; PG8_SCHED;
        }
        if (wr == 0) PG8_BAR;
        E(acc, cur, wr, wc, fr, fq);
        if (!has_next) break;
#pragma unroll
        for (int a = 0; a < 2; ++a)
#pragma unroll
            for (int b = 0; b < 2; ++b)
#pragma unroll
                for (int m = 0; m < 4; ++m)
#pragma unroll
                    for (int n = 0; n < 2; ++n) acc[a][b][m][n] = (f32x4){0.f, 0.f, 0.f, 0.f};
        cur = nxt; cA = nA; cB = nB; ++ui;
        if (wr == 1) PG8_BAR;
    }
    PG8_WAIT_V(0);
    PG8_BAR;
#undef PG8_SA
#undef PG8_SB
#undef PG8_STAGE
#undef PG8_LDA
#undef PG8_LDB
#undef PG8_MMA
#undef PG8_WAIT_V
#undef PG8_WAIT_L
#undef PG8_BAR
#undef PG8_SCHED
}
}
using pg8::Unit;

enum { K_Q = 0, K_K = 1, K_U = 2, K_G0 = 3, K_G1 = 4, K_VT = 5, K_VGT = 6 };

struct Epi1 {
    static constexpr int MID_T = 0;
    unsigned char* ws; const float* bgate;
    __device__ __forceinline__ void mid(f32x4 (&)[2][2][4][2], const Unit&, int, int, int, int) const {}
    __device__ __forceinline__ void operator()(const f32x4 (&acc)[2][2][4][2], const Unit& u, int wr, int wc, int fr, int fq) const {
        const int kind = u.kind;
        int rowb = u.r0 + wr * 64 + fr, colb = u.c0 + wc * 32 + 8 * fq;
        asm volatile("" : "+v"(rowb), "+v"(colb));
        if (kind == K_Q || kind == K_K || kind == K_U) {
            bf16_t* O = (bf16_t*)(ws + (kind == K_Q ? WS_Q : (kind == K_K ? WS_K : WS_UG)));
            const float sc = kind == K_Q ? QSCALE : 1.f;
#pragma unroll
            for (int ai = 0; ai < 2; ++ai)
#pragma unroll
                for (int m = 0; m < 4; ++m) { const int tok = rowb + ai * 128 + m * 16;
#pragma unroll
                    for (int bj = 0; bj < 2; ++bj) { f32x4 v0 = acc[ai][bj][m][0], v1 = acc[ai][bj][m][1]; const int col = colb + bj * 128;
                        bf16_t* dst = kind == K_U ? O + (unsigned)(tok * KP + col) : O + (unsigned)((((tok >> 5) * 8 + (col >> 6)) * 4 + ((col >> 4) & 3)) * 512 + ((col >> 3) & 1) * 256 + (tok & 31) * 8);
                        if (kind == K_U) {
#pragma unroll
                            for (int e = 0; e < 4; ++e) { v0[e] = gelu_tanh(v0[e]); v1[e] = gelu_tanh(v1[e]); } }
                        else { v0 = v0 * sc; v1 = v1 * sc; }
                        u32x4 w; w.x = pk_bf16(v0[0], v0[1]); w.y = pk_bf16(v0[2], v0[3]); w.z = pk_bf16(v1[0], v1[1]); w.w = pk_bf16(v1[2], v1[3]);
                        *(u32x4*)dst = w; } }
        } else if (kind == K_G0 || kind == K_G1) {
            unsigned short* O = (unsigned short*)(ws + (kind == K_G0 ? WS_G0 : WS_G1)); const float* bg = bgate + (kind == K_G0 ? 0 : D);
#pragma unroll
            for (int bj = 0; bj < 2; ++bj) { const f32x4 bv0 = *(const f32x4*)(bg + colb + bj * 128), bv1 = *(const f32x4*)(bg + colb + bj * 128 + 4);
#pragma unroll
                for (int ai = 0; ai < 2; ++ai)
#pragma unroll
                    for (int m = 0; m < 4; ++m) { f32x4 v0 = acc[ai][bj][m][0] + bv0, v1 = acc[ai][bj][m][1] + bv1;
#pragma unroll
                        for (int e = 0; e < 4; ++e) { v0[e] = sigmoidf_(v0[e]); v1[e] = sigmoidf_(v1[e]); }
                        u32x4 w; w.x = pk_f16(v0[0], v0[1]); w.y = pk_f16(v0[2], v0[3]); w.z = pk_f16(v1[0], v1[1]); w.w = pk_f16(v1[2], v1[3]);
                        *(u32x4*)(O + (unsigned)((rowb + ai * 128 + m * 16) * 1024 + colb + bj * 128)) = w; } }
        } else if (kind == K_VT) {
            bf16_t* VT = (bf16_t*)(ws + WS_VT);
#pragma unroll
            for (int ai = 0; ai < 2; ++ai)
#pragma unroll
                for (int m = 0; m < 4; ++m) { const int ch = rowb + ai * 128 + m * 16, hd = ch >> 6, dd = ch & 63;
#pragma unroll
                    for (int bj = 0; bj < 2; ++bj) { const f32x4 v0 = acc[ai][bj][m][0], v1 = acc[ai][bj][m][1]; const int t8 = colb + bj * 128;
                        const unsigned f = (unsigned)(((((t8 >> 6) * 8 + hd) * 2 + (dd >> 5)) * 2 + ((t8 >> 5) & 1)) * 2 + ((t8 >> 4) & 1));
                        bf16_t* dst = VT + f * 512 + (dd & 31) * 8 + 4 * ((t8 >> 3) & 1);
                        u32x2 w0, w1; w0.x = pk_bf16(v0[0], v0[1]); w0.y = pk_bf16(v0[2], v0[3]); w1.x = pk_bf16(v1[0], v1[1]); w1.y = pk_bf16(v1[2], v1[3]);
                        *(u32x2*)dst = w0; *(u32x2*)(dst + 256) = w1; } }
        } else {
            bf16_t* VGT = (bf16_t*)(ws + WS_VGT); f32x2* stats = (f32x2*)(ws + WS_STATS);
            const int slot = (u.r0 >> 8) * 2 + wr;
#pragma unroll
            for (int bj = 0; bj < 2; ++bj)
#pragma unroll
                for (int n = 0; n < 2; ++n) {
                    f32x4 s0 = (f32x4){0.f, 0.f, 0.f, 0.f}, q0 = s0; const int t4 = colb + bj * 128 + 4 * n;
#pragma unroll
                    for (int ai = 0; ai < 2; ++ai)
#pragma unroll
                        for (int m = 0; m < 4; ++m) { f32x4 v0 = acc[ai][bj][m][n]; const int ch = rowb + ai * 128 + m * 16;
#pragma unroll
                            for (int e = 0; e < 4; ++e) v0[e] = gelu_tanh(v0[e]);
                            s0 += v0; q0 += v0 * v0;
                            u32x2 w; w.x = pk_bf16(v0[0], v0[1]); w.y = pk_bf16(v0[2], v0[3]);
                            *(u32x2*)(VGT + (unsigned)(((t4 >> 4) * 16 + (ch >> 5)) * 512 + ((t4 >> 3) & 1) * 256 + (ch & 31) * 8 + (t4 & 4))) = w; }
#pragma unroll
                    for (int e = 0; e < 4; ++e) { float a = s0[e], b = q0[e];
#pragma unroll
                        for (int o = 1; o < 16; o <<= 1) { a += __shfl_xor(a, o); b += __shfl_xor(b, o); }
                        if (fr == 0) stats[(size_t)(t4 + e) * 4 + slot] = (f32x2){a, b}; }
                    asm volatile("" ::: "memory");
                }
        }
    }
};

struct Epi2 {
    static constexpr int MID_T = 8;
    const unsigned short *G0, *G1; bf16_t* MG;
    __device__ __forceinline__ void mid(f32x4 (&acc)[2][2][4][2], const Unit& u, int wr, int wc, int fr, int fq) const {
        int rowb = u.r0 + wr * 64 + fr, colb = u.c0 + wc * 32 + 8 * fq;
        asm volatile("" : "+v"(rowb), "+v"(colb));
#pragma unroll
        for (int ai = 0; ai < 2; ++ai)
#pragma unroll
            for (int m = 0; m < 4; ++m) { const size_t off = (size_t)(rowb + ai * 128 + m * 16) * 1024 + colb;
#pragma unroll
                for (int bj = 0; bj < 2; ++bj) { const u32x4 a = *(const u32x4*)(G0 + off + bj * 128), b = *(const u32x4*)(G1 + off + bj * 128);
                    f32x4 r0, r1;
                    r0[0] = h_lo(a.x) * frcp(h_lo(b.x)); r0[1] = h_hi(a.x) * frcp(h_hi(b.x)); r0[2] = h_lo(a.y) * frcp(h_lo(b.y)); r0[3] = h_hi(a.y) * frcp(h_hi(b.y));
                    r1[0] = h_lo(a.z) * frcp(h_lo(b.z)); r1[1] = h_hi(a.z) * frcp(h_hi(b.z)); r1[2] = h_lo(a.w) * frcp(h_lo(b.w)); r1[3] = h_hi(a.w) * frcp(h_hi(b.w));
                    acc[ai][bj][m][0] *= r0; acc[ai][bj][m][1] *= r1; }
                asm volatile("" ::: "memory"); }
    }
    __device__ __forceinline__ void operator()(const f32x4 (&acc)[2][2][4][2], const Unit& u, int wr, int wc, int fr, int fq) const {
        const int rowb = u.r0 + wr * 64 + fr, colb = u.c0 + wc * 32 + 8 * fq;
#pragma unroll
        for (int ai = 0; ai < 2; ++ai)
#pragma unroll
            for (int m = 0; m < 4; ++m) { const size_t off = (size_t)(rowb + ai * 128 + m * 16) * 1024 + colb;
#pragma unroll
                for (int bj = 0; bj < 2; ++bj) { const u32x4 b = *(const u32x4*)(G1 + off + bj * 128);
                    const f32x4 v0 = acc[ai][bj][m][0], v1 = acc[ai][bj][m][1];
                    u32x4 w; w.x = pk_bf16(v0[0] * h_lo(b.x), v0[1] * h_hi(b.x)); w.y = pk_bf16(v0[2] * h_lo(b.y), v0[3] * h_hi(b.y));
                    w.z = pk_bf16(v1[0] * h_lo(b.z), v1[1] * h_hi(b.z)); w.w = pk_bf16(v1[2] * h_lo(b.w), v1[3] * h_hi(b.w));
                    *(u32x4*)(MG + off + bj * 128) = w; }
                asm volatile("" ::: "memory"); }
    }
};

struct Epi3 {
    static constexpr int MID_T = 0;
    const float* base; float* out;
    __device__ __forceinline__ void mid(f32x4 (&)[2][2][4][2], const Unit&, int, int, int, int) const {}
    __device__ __forceinline__ void operator()(const f32x4 (&acc)[2][2][4][2], const Unit& u, int wr, int wc, int fr, int fq) const {
        const int rowb = u.r0 + wr * 64 + fr, colb = u.c0 + wc * 32 + 8 * fq;
#pragma unroll
        for (int ai = 0; ai < 2; ++ai)
#pragma unroll
            for (int m = 0; m < 4; ++m) { const size_t off = (size_t)(rowb + ai * 128 + m * 16) * D + colb;
#pragma unroll
                for (int bj = 0; bj < 2; ++bj) { const f32x4 b0 = *(const f32x4*)(base + off + bj * 128), b1 = *(const f32x4*)(base + off + bj * 128 + 4);
                    *(f32x4*)(out + off + bj * 128) = b0 + acc[ai][bj][m][0]; *(f32x4*)(out + off + bj * 128 + 4) = b1 + acc[ai][bj][m][1]; }
                asm volatile("" ::: "memory"); }
    }
};

struct Epi4 {
    static constexpr int MID_T = 0;
    bf16_t* ACT;
    __device__ __forceinline__ void mid(f32x4 (&)[2][2][4][2], const Unit&, int, int, int, int) const {}
    __device__ __forceinline__ void operator()(const f32x4 (&acc)[2][2][4][2], const Unit& u, int wr, int wc, int fr, int fq) const {
        const int rowb = u.r0 + wr * 64 + fr, colb = u.c0 + wc * 32 + 8 * fq;
#pragma unroll
        for (int ai = 0; ai < 2; ++ai)
#pragma unroll
            for (int m = 0; m < 4; ++m) { const f32x4 g0 = acc[ai][0][m][0], g1 = acc[ai][0][m][1], u0 = acc[ai][1][m][0], u1 = acc[ai][1][m][1]; f32x4 v0, v1;
#pragma unroll
                for (int e = 0; e < 4; ++e) { v0[e] = g0[e] * sigmoidf_(g0[e]) * u0[e]; v1[e] = g1[e] * sigmoidf_(g1[e]) * u1[e]; }
                u32x4 w; w.x = pk_bf16(v0[0], v0[1]); w.y = pk_bf16(v0[2], v0[3]); w.z = pk_bf16(v1[0], v1[1]); w.w = pk_bf16(v1[2], v1[3]);
                *(u32x4*)(ACT + (size_t)(rowb + ai * 128 + m * 16) * DFF + colb) = w; }
    }
};

struct Sched1 {
    const bf16_t* XN; const bf16_t* WT; int G, c;
    __device__ __forceinline__ bool next(int i, Unit& u) const {
        const int L = i * G + c; if (L >= 1152) return false;
        const int x = L & 7, off = L >> 3;
        if (off < 112) { const int pm = 8 * x + (off & 7), t = off >> 3;
            const int wt = t < 4 ? t : (t < 6 ? t + 2 : t + 4);
            u.A = (const char*)(XN + (size_t)pm * 256 * D); u.B = (const char*)(WT + (size_t)wt * 256 * D); u.r0 = pm * 256;
            if (t < 2) { u.kind = K_Q; u.c0 = t * 256; } else if (t < 4) { u.kind = K_K; u.c0 = (t - 2) * 256; } else if (t < 6) { u.kind = K_U; u.c0 = (t - 4) * 256; }
            else if (t < 10) { u.kind = K_G0; u.c0 = (t - 6) * 256; } else { u.kind = K_G1; u.c0 = (t - 10) * 256; }
        } else { const int o2 = off - 112, pn = 8 * x + (o2 & 7), w = o2 >> 3;
            const int wt = w < 2 ? 4 + w : 6 + w;
            u.A = (const char*)(WT + (size_t)wt * 256 * D); u.B = (const char*)(XN + (size_t)pn * 256 * D);
            u.kind = w < 2 ? K_VT : K_VGT; u.r0 = (w & 1) * 256; u.c0 = pn * 256; }
        return true;
    }
};
struct SchedN {
    const bf16_t* A; const bf16_t* Bt; int K, nN, cw, G, c;
    __device__ __forceinline__ bool next(int i, Unit& u) const {
        const int L = i * G + c; if (L >= 64 * nN) return false;
        const int x = L & 7, off = L >> 3, pm = 8 * x + (off & 7), pn = off >> 3;
        u.A = (const char*)(A + (size_t)pm * 256 * K); u.B = (const char*)(Bt + (size_t)pn * 256 * K); u.kind = 0; u.r0 = pm * 256; u.c0 = pn * cw; return true;
    }
};

#define XB_TMO      128
#define XB_XCNT(j)  (256  + 64 * (j))
#define XB_XSUB(j)  (1280 + 64 * (j))
#define XB_XGEN(j)  (2304 + 64 * (j))
#define XB_TOP      3328
#define XB_TOPGEN   3392
#define XCD_BAR_WORDS 3456
#define XB_SPIN_CAP (1u << 18)
__device__ __forceinline__ unsigned xb_ld(unsigned* p)              { return __hip_atomic_load(p, __ATOMIC_RELAXED, __HIP_MEMORY_SCOPE_AGENT); }
__device__ __forceinline__ unsigned xb_add(unsigned* p, unsigned v) { return __hip_atomic_fetch_add(p, v, __ATOMIC_RELAXED, __HIP_MEMORY_SCOPE_AGENT); }
__device__ __forceinline__ unsigned xb_xcc_id() { return (unsigned)__builtin_amdgcn_s_getreg((3 << 11) | 20) & 0xFu; }
#define XB_SPIN(cond, bar) do { unsigned _sp = 0; while (cond) { __builtin_amdgcn_s_sleep(1); \
    if ((++_sp & 255u) == 0u) { if (xb_ld(&(bar)[XB_TMO])) break; if (_sp > XB_SPIN_CAP) { atomicAdd(&(bar)[XB_TMO], 1u); break; } } } } while (0)
struct XcdBarrier { unsigned* bar; unsigned x; volatile LAS unsigned* st; };
__device__ __forceinline__ XcdBarrier xcd_barrier_post(unsigned* bar, volatile LAS unsigned* st) {
    XcdBarrier b; b.bar = bar; b.x = xb_xcc_id(); b.st = st;
    if (threadIdx.x == 0) (void)xb_add(&bar[XB_XCNT(b.x)], 1u);
    return b;
}
__device__ __forceinline__ void xcd_barrier_complete(unsigned* bar, unsigned x, unsigned& nloc, unsigned& nx) {
    const unsigned G = gridDim.x * gridDim.y * gridDim.z;
    unsigned sum, cnt, mine, sp = 0u;
    for (;;) {
        sum = 0u; cnt = 0u; mine = 0u;
#pragma unroll
        for (unsigned j = 0; j < 16; ++j) { const unsigned c = xb_ld(&bar[XB_XCNT(j)]); sum += c; cnt += (c > 0u) ? 1u : 0u; mine = (j == x) ? c : mine; }
        if (sum == G) break;
        __builtin_amdgcn_s_sleep(1);
        if ((++sp & 255u) == 0u) { if (xb_ld(&bar[XB_TMO])) break; if (sp > XB_SPIN_CAP) { atomicAdd(&bar[XB_TMO], 1u); break; } }
    }
    nloc = mine > 0u ? mine : 1u; nx = cnt > 0u ? cnt : 1u;
}
__device__ __forceinline__ void xcd_barrier(const XcdBarrier& b) {
    asm volatile("s_waitcnt vmcnt(0)" ::: "memory");
    __syncthreads();
    if (threadIdx.x == 0) {
        unsigned* bar = b.bar;
        __builtin_amdgcn_s_waitcnt(0);
        unsigned nloc = b.st[0], nx = b.st[1];
        if (nloc == 0u) { xcd_barrier_complete(bar, b.x, nloc, nx); b.st[0] = nloc; b.st[1] = nx; }
        const unsigned old = xb_add(&bar[XB_XSUB(b.x)], 1u);
        const unsigned gen = old / nloc;
        if (old + 1u == (gen + 1u) * nloc) {
            __builtin_amdgcn_fence(__ATOMIC_RELEASE, "agent");
            asm volatile("s_waitcnt vmcnt(0)" ::: "memory");
            const unsigned og = xb_add(&bar[XB_TOP], 1u);
            const unsigned tg = og / nx;
            if (og + 1u == (tg + 1u) * nx) xb_add(&bar[XB_TOPGEN], 1u);
            else XB_SPIN(xb_ld(&bar[XB_TOPGEN]) == tg, bar);
            __builtin_amdgcn_fence(__ATOMIC_ACQUIRE, "agent");
            xb_add(&bar[XB_XGEN(b.x)], 1u);
            asm volatile("s_waitcnt vmcnt(0)" ::: "memory");
        } else {
            XB_SPIN(xb_ld(&bar[XB_XGEN(b.x)]) == gen, bar);
            __builtin_amdgcn_fence(__ATOMIC_ACQUIRE, "agent");
            asm volatile("s_waitcnt vmcnt(0)" ::: "memory");
        }
    }
    __syncthreads();
}

struct Args { const float* in[16]; float* out; unsigned char* ws; int ph_lo, ph_hi; };

__device__ __forceinline__ void transpose_item(const float* W, int N, bf16_t* WT, int ldk, int koff, int k0, int n0, int drow0, LAS float* scr, int lane) {
#pragma unroll 8
    for (int i = 0; i < 32; ++i) { const int kk = 2 * i + (lane >> 5); scr[kk * 33 + (lane & 31)] = W[(size_t)(k0 + kk) * N + n0 + (lane & 31)]; }
    asm volatile("s_waitcnt lgkmcnt(0)" ::: "memory");
    const int c = lane & 7;
#pragma unroll
    for (int j = 0; j < 4; ++j) { const int n = (lane >> 3) + 8 * j; const LAS float* s = scr + (8 * c) * 33 + n;
        u32x4 o; o.x = pk_bf16(s[0 * 33], s[1 * 33]); o.y = pk_bf16(s[2 * 33], s[3 * 33]); o.z = pk_bf16(s[4 * 33], s[5 * 33]); o.w = pk_bf16(s[6 * 33], s[7 * 33]);
        *(u32x4*)(WT + (size_t)(drow0 + n) * ldk + koff + k0 + 8 * c) = o; }
    asm volatile("s_waitcnt lgkmcnt(0)" ::: "memory");
}
__device__ __forceinline__ void rms_row_bf16(const float* xrow, const float* g, bf16_t* orow, int lane) {
    const f32x4* xr = (const f32x4*)xrow + lane; const f32x4* gr = (const f32x4*)g + lane;
    f32x4 v[4]; float s = 0.f;
#pragma unroll
    for (int j = 0; j < 4; ++j) { v[j] = xr[64 * j]; s += (v[j].x * v[j].x + v[j].y * v[j].y) + (v[j].z * v[j].z + v[j].w * v[j].w); }
    const float r = 1.0f / sqrtf(wave_sum(s) * (1.f / D) + EPS);
    u32x2* o8 = (u32x2*)orow + lane;
#pragma unroll
    for (int j = 0; j < 4; ++j) { const f32x4 q = gr[64 * j]; u32x2 w; w.x = pk_bf16(v[j].x * r * q.x, v[j].y * r * q.y); w.y = pk_bf16(v[j].z * r * q.z, v[j].w * r * q.w); o8[64 * j] = w; }
}
__device__ __forceinline__ void rms_row_f32(const float* xrow, const float* g, float* orow, int lane) {
    const f32x4* xr = (const f32x4*)xrow + lane; const f32x4* gr = (const f32x4*)g + lane;
    f32x4 v[4]; float s = 0.f;
#pragma unroll
    for (int j = 0; j < 4; ++j) { v[j] = xr[64 * j]; s += (v[j].x * v[j].x + v[j].y * v[j].y) + (v[j].z * v[j].z + v[j].w * v[j].w); }
    const float r = 1.0f / sqrtf(wave_sum(s) * (1.f / D) + EPS);
    f32x4* o = (f32x4*)orow + lane;
#pragma unroll
    for (int j = 0; j < 4; ++j) { const f32x4 q = gr[64 * j]; o[64 * j] = v[j] * r * q; }
}

constexpr float ATT_THR = 6.0f;
constexpr int TABN = 320, TAB_BYTES = 4 * TABN * 4;
__device__ __forceinline__ float halfmax(float m) { auto rr = __builtin_amdgcn_permlane32_swap(__float_as_uint(m), __float_as_uint(m), false, false); return fmaxf(__uint_as_float(rr[0]), __uint_as_float(rr[1])); }
#define MX3(a, b, c) __builtin_fmaxf(__builtin_fmaxf((a), (b)), (c))
template <int VAR> __device__ __forceinline__ void attn_unit(int b, int c, const bf16_t* Q, const bf16_t* Kb, const bf16_t* VT, bf16_t* AS, const float* relb, LAS float* tab, LAS unsigned char* qlds, int wid, int lane) {
    const int r32 = lane & 31, hi = lane >> 5;
    const int t0 = b * SEQ + 64 * c;
    const int kt0 = c >= 8 ? 0 : 8 - c;
    const bf16_t* kptr = Kb + ((ptrdiff_t)((t0 - 512) >> 5) * 8 + wid) * 2048 + lane * 8;
    const bf16_t* vptr = VT + ((ptrdiff_t)((t0 - 512) >> 6) * 8 + wid) * 4096 + lane * 8;
    bf16x8 kf[2][4];
#pragma unroll
    for (int kh = 0; kh < 2; ++kh)
#pragma unroll
        for (int d0 = 0; d0 < 4; ++d0) kf[kh][d0] = *(const bf16x8*)(kptr + (2 * kt0 + kh) * 16384 + d0 * 512);
    for (int i = lane; i < 4 * TABN; i += 64) { const int cc = i / TABN, k = i - cc * TABN; int e = 319 - (k + cc); e = e < 0 ? 0 : (e > 256 ? 256 : e); tab[i] = relb[wid * 257 + e] * LOG2E; }
    const float c256 = relb[wid * 257 + 256] * LOG2E;
#pragma unroll
    for (int qb = 0; qb < 2; ++qb)
#pragma unroll
        for (int d0 = 0; d0 < 4; ++d0) *(LAS bf16x8*)(qlds + (qb * 4 + d0) * 1024 + lane * 16) = *(const bf16x8*)(Q + ((size_t)((t0 >> 5) + qb) * 8 + wid) * 2048 + d0 * 512 + lane * 8);
    f32x16 o[2][2];
#pragma unroll
    for (int db = 0; db < 2; ++db)
#pragma unroll
        for (int qb = 0; qb < 2; ++qb)
#pragma unroll
            for (int r = 0; r < 16; ++r) o[db][qb][r] = 0.f;
    float mref[2] = {-1e30f, -1e30f}, lrun[2] = {0.f, 0.f};
    for (int kt = kt0; kt < 9; ++kt) {
        bf16x8 vf[2][2][2];
#pragma unroll
        for (int db = 0; db < 2; ++db)
#pragma unroll
            for (int kh = 0; kh < 2; ++kh)
#pragma unroll
                for (int s = 0; s < 2; ++s) vf[db][kh][s] = *(const bf16x8*)(vptr + ((VAR & 1) ? kt0 : kt) * 32768 + ((db * 2 + kh) * 2 + s) * 512);
        u32x4 pk[2][2][2];
        LAS unsigned char* qp = qlds + lane * 16; asm volatile("" : "+v"(qp));
#pragma unroll
        for (int qb = 0; qb < 2; ++qb) {
            f32x16 p0, p1; float cadd;
            if (kt < 6) { cadd = c256;
                const f32x16 z = {0.f, 0.f, 0.f, 0.f, 0.f, 0.f, 0.f, 0.f, 0.f, 0.f, 0.f, 0.f, 0.f, 0.f, 0.f, 0.f};
                { const bf16x8 qfr = *(const LAS bf16x8*)(qp + (qb * 4) * 1024);
                  p0 = __builtin_amdgcn_mfma_f32_32x32x16_bf16(kf[0][0], qfr, z, 0, 0, 0); p1 = __builtin_amdgcn_mfma_f32_32x32x16_bf16(kf[1][0], qfr, z, 0, 0, 0); }
#pragma unroll
                for (int d0 = 1; d0 < 4; ++d0) { const bf16x8 qfr = *(const LAS bf16x8*)(qp + (qb * 4 + d0) * 1024);
                    p0 = __builtin_amdgcn_mfma_f32_32x32x16_bf16(kf[0][d0], qfr, p0, 0, 0, 0); p1 = __builtin_amdgcn_mfma_f32_32x32x16_bf16(kf[1][d0], qfr, p1, 0, 0, 0); }
            } else { cadd = 0.f;
                const int a0 = 319 - (640 + 32 * qb + r32 - 64 * kt - 4 * hi), sh = a0 & 3;
                const LAS f32x4* tp = (const LAS f32x4*)(tab + sh * TABN + (a0 & ~3));
#pragma unroll
                for (int g4 = 0; g4 < 4; ++g4) { const f32x4 v0 = tp[2 * g4], v1 = tp[2 * g4 + 8];
#pragma unroll
                    for (int e = 0; e < 4; ++e) { p0[4 * g4 + e] = v0[e]; p1[4 * g4 + e] = v1[e]; } }
#pragma unroll
                for (int d0 = 0; d0 < 4; ++d0) { const bf16x8 qfr = *(const LAS bf16x8*)(qp + (qb * 4 + d0) * 1024);
                    p0 = __builtin_amdgcn_mfma_f32_32x32x16_bf16(kf[0][d0], qfr, p0, 0, 0, 0); p1 = __builtin_amdgcn_mfma_f32_32x32x16_bf16(kf[1][d0], qfr, p1, 0, 0, 0); }
            }
            if (qb == 1) {
                const int ktn = (VAR & 1) ? kt0 : (kt < 8 ? kt + 1 : 8);
                __builtin_amdgcn_sched_barrier(0);
#pragma unroll
                for (int kh = 0; kh < 2; ++kh)
#pragma unroll
                    for (int d0 = 0; d0 < 4; ++d0) kf[kh][d0] = *(const bf16x8*)(kptr + (2 * ktn + kh) * 16384 + d0 * 512);
                __builtin_amdgcn_sched_barrier(0);
            }
            float ma = MX3(p0[0], p0[1], p1[0]), mb = MX3(p0[2], p0[3], p1[1]); ma = MX3(ma, p1[2], p1[3]);
#pragma unroll
            for (int r = 4; r < 16; r += 4) { ma = MX3(ma, p0[r], p0[r + 1]); mb = MX3(mb, p0[r + 2], p0[r + 3]); ma = MX3(ma, p1[r], p1[r + 1]); mb = MX3(mb, p1[r + 2], p1[r + 3]); }
            const float mx = halfmax(fmaxf(ma, mb)) + cadd;
            if (__any(mx - mref[qb] > ATT_THR)) {
                const float nref = (mx - mref[qb] > ATT_THR) ? mx : mref[qb], alpha = fexp2(mref[qb] - nref);
                mref[qb] = nref; lrun[qb] *= alpha;
#pragma unroll
                for (int r = 0; r < 16; ++r) { o[0][qb][r] *= alpha; o[1][qb][r] *= alpha; }
            }
            const float sub = mref[qb] - cadd;
            float rs0 = 0.f, rs1 = 0.f;
#pragma unroll
            for (int r = 0; r < 16; ++r) { if (VAR & 2) { p0[r] = p0[r] - sub; p1[r] = p1[r] - sub; } else { p0[r] = fexp2(p0[r] - sub); p1[r] = fexp2(p1[r] - sub); } rs0 += p0[r]; rs1 += p1[r]; }
            lrun[qb] += rs0 + rs1;
#pragma unroll
            for (int s = 0; s < 2; ++s) {
                pk[qb][0][s] = (u32x4){pk_bf16(p0[8 * s], p0[8 * s + 1]), pk_bf16(p0[8 * s + 2], p0[8 * s + 3]), pk_bf16(p0[8 * s + 4], p0[8 * s + 5]), pk_bf16(p0[8 * s + 6], p0[8 * s + 7])};
                pk[qb][1][s] = (u32x4){pk_bf16(p1[8 * s], p1[8 * s + 1]), pk_bf16(p1[8 * s + 2], p1[8 * s + 3]), pk_bf16(p1[8 * s + 4], p1[8 * s + 5]), pk_bf16(p1[8 * s + 6], p1[8 * s + 7])};
            }
        }
#pragma unroll
        for (int db = 0; db < 2; ++db)
#pragma unroll
            for (int qb = 0; qb < 2; ++qb)
#pragma unroll
                for (int kh = 0; kh < 2; ++kh)
#pragma unroll
                    for (int s = 0; s < 2; ++s) { if (VAR & 8) { o[db][qb][0] += __uint_as_float(pk[qb][kh][s].x) + __uint_as_float((unsigned)vf[db][kh][s][0]); } else o[db][qb] = __builtin_amdgcn_mfma_f32_32x32x16_bf16(vf[db][kh][s], __builtin_bit_cast(bf16x8, pk[qb][kh][s]), o[db][qb], 0, 0, 0); }
    }
#pragma unroll
    for (int qb = 0; qb < 2; ++qb) {
        const float l = lrun[qb] + __shfl_xor(lrun[qb], 32), inv = 1.0f / l;
        bf16_t* orow = AS + (size_t)(t0 + 32 * qb + r32) * D + 64 * wid + 4 * hi;
#pragma unroll
        for (int db = 0; db < 2; ++db)
#pragma unroll
            for (int g4 = 0; g4 < 4; ++g4) { u32x2 w; w.x = pk_bf16(o[db][qb][4 * g4] * inv, o[db][qb][4 * g4 + 1] * inv); w.y = pk_bf16(o[db][qb][4 * g4 + 2] * inv, o[db][qb][4 * g4 + 3] * inv);
                if (!(VAR & 4) || inv == 12345.678f) *(u32x2*)(orow + 32 * db + 8 * g4) = w; }
    }
}
#undef MX3

__device__ __forceinline__ void sgu_task(int task, const bf16_t* VGT, const bf16_t* UG, const f32x2* stats, const bf16_t* SGWb, const float* R2, const float* bs, const float* lng, const float* lnb,
                                         bf16_t* AS, LAS f32x2* st  , int lane) {
    const int r32 = lane & 31, hi = lane >> 5;
    const int cb = task & 3, g = (task >> 2) & 3, n = task >> 4, tok0 = 128 * n;
    const bf16_t* vrow = VGT + ((size_t)(tok0 >> 4) * 16 + g * 4 + cb) * 512 + lane * 8;
    u32x4 raw[8];
#pragma unroll
    for (int s = 0; s < 8; ++s) raw[s] = *(const u32x4*)(vrow + s * 8192);
#pragma unroll
    for (int j = 0; j < 2; ++j) { const f32x2* sp = stats + (size_t)(tok0 + lane + 64 * j) * 4; const f32x2 a = sp[0], b = sp[1], c = sp[2], d = sp[3];
        const float S = (a.x + b.x) + (c.x + d.x), Q2 = (a.y + b.y) + (c.y + d.y), mu = S * (1.f / SW), var = fmaxf(Q2 * (1.f / SW) - mu * mu, 0.f);
        st[lane + 64 * j] = (f32x2){mu, 1.0f / sqrtf(var + EPS)}; }
    bf16x8 af[8];
#pragma unroll
    for (int s = 0; s < 8; ++s) {
        const LAS f32x4* sp = (const LAS f32x4*)(st + 16 * s + 8 * hi);
        const f32x4 m01 = sp[0], m23 = sp[1], m45 = sp[2], m67 = sp[3];
        u32x4 a;
        a.x = pk_bf16((bf_lo(raw[s].x) - m01[0]) * m01[1], (bf_hi(raw[s].x) - m01[2]) * m01[3]);
        a.y = pk_bf16((bf_lo(raw[s].y) - m23[0]) * m23[1], (bf_hi(raw[s].y) - m23[2]) * m23[3]);
        a.z = pk_bf16((bf_lo(raw[s].z) - m45[0]) * m45[1], (bf_hi(raw[s].z) - m45[2]) * m45[3]);
        a.w = pk_bf16((bf_lo(raw[s].w) - m67[0]) * m67[1], (bf_hi(raw[s].w) - m67[2]) * m67[3]);
        af[s] = __builtin_bit_cast(bf16x8, a);
    }
#pragma unroll
    for (int tp = 0; tp < 2; ++tp) {
        bf16x8 wf[2][8];
#pragma unroll
        for (int tbi = 0; tbi < 2; ++tbi)
#pragma unroll
            for (int s = 0; s < 8; ++s) wf[tbi][s] = *(const bf16x8*)(SGWb + (((g * 4 + 2 * tp + tbi) * 8 + s) * 512) + lane * 8);
#pragma unroll
        for (int tbi = 0; tbi < 2; ++tbi) {
            const int t = 32 * (2 * tp + tbi) + r32;
            const size_t tok = (size_t)(tok0 + t);
            const float r2t = R2[g * 128 + t], bst = bs[g * 128 + t];
            u32x2 ugv[4];
#pragma unroll
            for (int q4 = 0; q4 < 4; ++q4) ugv[q4] = *(const u32x2*)(UG + tok * KP + 128 * g + 32 * cb + 8 * q4 + 4 * hi);
            f32x16 acc;
#pragma unroll
            for (int r = 0; r < 16; ++r) acc[r] = 0.f;
#pragma unroll
            for (int s = 0; s < 8; ++s) acc = __builtin_amdgcn_mfma_f32_32x32x16_bf16(af[s], wf[tbi][s], acc, 0, 0, 0);
#pragma unroll
            for (int q4 = 0; q4 < 4; ++q4) { const int ch = 128 * g + 32 * cb + 8 * q4 + 4 * hi;
                const f32x4 lg = *(const f32x4*)(lng + ch), lb = *(const f32x4*)(lnb + ch);
                const float v0 = bf_lo(ugv[q4].x) * (lg[0] * acc[4 * q4] + lb[0] * r2t + bst), v1 = bf_hi(ugv[q4].x) * (lg[1] * acc[4 * q4 + 1] + lb[1] * r2t + bst);
                const float v2 = bf_lo(ugv[q4].y) * (lg[2] * acc[4 * q4 + 2] + lb[2] * r2t + bst), v3 = bf_hi(ugv[q4].y) * (lg[3] * acc[4 * q4 + 3] + lb[3] * r2t + bst);
                u32x2 w; w.x = pk_bf16(v0, v1); w.y = pk_bf16(v2, v3);
                *(u32x2*)(AS + tok * D + 512 + ch) = w; }
        }
    }
}

constexpr int LDS_BYTES = 147456;
constexpr int MISC_OFF = 131072 + 320;

__global__ void __launch_bounds__(NTHREADS, 2) mega_fwd(Args args) {
    extern __shared__ __attribute__((aligned(16))) unsigned char lds_raw[];
    LAS unsigned char* lds = (LAS unsigned char*)lds_raw;
    volatile LAS unsigned* MISC = (volatile LAS unsigned*)(lds + MISC_OFF);
    const int tid = threadIdx.x, lane = tid & 63, wid = __builtin_amdgcn_readfirstlane(tid >> 6);
    const int G = gridDim.x, bx = blockIdx.x;
    const int vcu = (G % 8 == 0) ? (bx % 8) * (G / 8) + bx / 8 : bx;
    unsigned char* ws = args.ws;
    unsigned* ctl = (unsigned*)(ws + WS_CTL);
    for (int u = tid; u < (LDS_BYTES - 131072) / 4; u += NTHREADS) ((LAS unsigned*)(lds + 131072))[u] = 0u;
    __syncthreads();
    XcdBarrier bar; bar.bar = ctl + CW_BAR; bar.x = 0; bar.st = nullptr;
    if (MK_LAUNCHES == 1) bar = xcd_barrier_post(ctl + CW_BAR, MISC + 8);
    const int lo = args.ph_lo, hi_ = args.ph_hi;
#ifndef PH_MASK
#define PH_MASK 0x1ff
#endif
#define IN(k) (lo <= (k) && (k) < hi_)
#define PHON(j) ((PH_MASK >> (j)) & 1)
#define SEAM(k) do { if (MK_LAUNCHES == 1 && IN((k) + 1)) xcd_barrier(bar); } while (0)

    const float* x = args.in[0]; float* H = args.out;
#define P_XN   ((bf16_t*)(ws + WS_XN))
#define P_Q    ((bf16_t*)(ws + WS_Q))
#define P_K    ((bf16_t*)(ws + WS_K))
#define P_VT   ((bf16_t*)(ws + WS_VT))
#define P_UG   ((bf16_t*)(ws + WS_UG))
#define P_VGT  ((bf16_t*)(ws + WS_VGT))
#define P_G0   ((unsigned short*)(ws + WS_G0))
#define P_G1   ((unsigned short*)(ws + WS_G1))
#define P_MG   ((bf16_t*)(ws + WS_MG))
#define P_ACT  ((bf16_t*)(ws + WS_ACT))
#define P_STATS ((f32x2*)(ws + WS_STATS))
#define P_SGWB ((bf16_t*)(ws + WS_SGWB))
#define P_R2   ((float*)(ws + WS_R2))
    const int gw = vcu * NWAVES + wid, NGW = G * NWAVES;

    if (PHON(0) && IN(0)) { for (int rep_ = 0; rep_ < (PROBE_REP == 0 ? 2 : 1); ++rep_) {
        LAS float* scr = (LAS float*)(lds + wid * 16384);
        constexpr int I_IN = 16 * 144, I_BA = 8 * 32, I_BS = 8 * 32, I_OUT = 16 * 32, I_FI = 16 * 176, I_FO = 44 * 32, I_LAYER = I_IN + I_BA + I_BS + I_OUT + I_FI + I_FO;
        for (int it = gw; it < DEPTH * I_LAYER; it += NGW) {
            const int l = it / I_LAYER; int r = it % I_LAYER;
            unsigned char* wl = ws + WS_W + (size_t)l * W_LAYER;
            if (r < I_IN) { const int kb = r / 144, nb = r % 144; transpose_item(args.in[2] + (size_t)l * D * INW, INW, (bf16_t*)(wl + W_IN), D, 0, 64 * kb, 32 * nb, 32 * nb, scr, lane); continue; } r -= I_IN;
            if (r < I_BA) { const int kb = r / 32, nb = r % 32; transpose_item(args.in[8] + (size_t)l * AW * D, D, (bf16_t*)(wl + W_BR), D, 0, 64 * kb, 32 * nb, 32 * nb, scr, lane); continue; } r -= I_BA;
            if (r < I_BS) { const int kb = r / 32, nb = r % 32; transpose_item(args.in[9] + (size_t)l * SW * D, D, (bf16_t*)(wl + W_BR), D, 512, 64 * kb, 32 * nb, 32 * nb, scr, lane); continue; } r -= I_BS;
            if (r < I_OUT) { const int kb = r / 32, nb = r % 32; transpose_item(args.in[11] + (size_t)l * D * D, D, (bf16_t*)(wl + W_OUT), D, 0, 64 * kb, 32 * nb, 32 * nb, scr, lane); continue; } r -= I_OUT;
            if (r < I_FI) { const int kb = r / 176, nb = r % 176, n0 = 32 * nb;
                const int nn = n0 < DFF ? n0 : n0 - DFF, drow = 256 * (nn / 128) + (nn % 128) + (n0 < DFF ? 0 : 128);
                transpose_item(args.in[13] + (size_t)l * D * 2 * DFF, 2 * DFF, (bf16_t*)(wl + W_FI), D, 0, 64 * kb, n0, drow, scr, lane); continue; } r -= I_FI;
            { const int kb = r / 32, nb = r % 32; transpose_item(args.in[14] + (size_t)l * DFF * D, D, (bf16_t*)(wl + W_FO), DFF, 0, 64 * kb, 32 * nb, 32 * nb, scr, lane); }
        }
        for (int row = gw; row < DEPTH * 4 * 128; row += NGW) { const int t = row & 127; const float* wr_ = args.in[6] + (size_t)row * 128;
            const float a = (lane <= t) ? wr_[lane] : 0.f, b = (lane + 64 <= t) ? wr_[lane + 64] : 0.f;
            { const int lg = row >> 7;
              bf16_t* fb = P_SGWB + (size_t)((lg * 4 + (t >> 5)) * 8) * 512 + (t & 31) * 8;
              fb[(lane >> 4) * 512 + ((lane >> 3) & 1) * 256 + (lane & 7)] = (bf16_t)(pk_bf16(a, 0.f) & 0xffffu);
              fb[((lane + 64) >> 4) * 512 + ((lane >> 3) & 1) * 256 + (lane & 7)] = (bf16_t)(pk_bf16(b, 0.f) & 0xffffu); }
            const float s = wave_sum(a + b); if (lane == 0) P_R2[row] = s; }
        for (int m = gw; m < M; m += NGW) rms_row_bf16(x + (size_t)m * D, args.in[1], P_XN + (size_t)m * D, lane);
        }
        SEAM(0);
    }
    for (int l = 0; l < DEPTH; ++l) {
        const int pb = 1 + 8 * l;
        unsigned char* wl = ws + WS_W + (size_t)l * W_LAYER;
        if (PHON(1) && IN(pb + 0)) { for (int rep_ = 0; rep_ < (PROBE_REP == pb + 0 ? 2 : 1); ++rep_) {
            Sched1 S{P_XN, (const bf16_t*)(wl + W_IN), G, bx};
            Epi1 E{ws, args.in[10] + (size_t)l * 2 * D};
            pg8::gemm_phase<Epi1, Sched1>(lds, D, S, E);
            }
            SEAM(pb + 0);
        }
        if (PHON(2) && IN(pb + 1)) { for (int rep_ = 0; rep_ < (PROBE_REP == pb + 1 ? 2 : 1); ++rep_) {
            int tid = threadIdx.x; asm volatile("" : "+v"(tid));
            const int lane = tid & 63, wid = __builtin_amdgcn_readfirstlane(tid >> 6);
            if (rep_ == 1 && PROBE_SUB >= 16) { for (int uu = vcu; uu < 256; uu += G) attn_unit<(PROBE_SUB & 15) | 4>(uu >> 6, uu & 63, P_Q, P_K, P_VT, P_XN, args.in[3] + (size_t)l * NH * 257, (LAS float*)(lds + wid * TAB_BYTES), lds + 65536 + wid * 8192, wid, lane); }
            else if (rep_ == 0 || PROBE_SUB != 2) for (int uu = vcu; uu < 256; uu += G) attn_unit<0>(uu >> 6, uu & 63, P_Q, P_K, P_VT, P_XN, args.in[3] + (size_t)l * NH * 257, (LAS float*)(lds + wid * TAB_BYTES), lds + 65536 + wid * 8192, wid, lane);
            if (rep_ == 0 || (PROBE_SUB != 1 && PROBE_SUB < 16)) for (int task = vcu * NWAVES + wid; task < 2048; task += G * NWAVES) sgu_task(task, P_VGT, P_UG, P_STATS, P_SGWB + (size_t)l * 4 * 128 * 128, P_R2 + l * 512, args.in[7] + l * 512, args.in[4] + l * SW, args.in[5] + l * SW,
                                                           P_XN, (LAS f32x2*)(lds + 49152 + wid * 1024), lane);
            }
            SEAM(pb + 1);
        }
        if (PHON(3) && IN(pb + 2)) { for (int rep_ = 0; rep_ < (PROBE_REP == pb + 2 ? 2 : 1); ++rep_) {
            SchedN S{P_XN, (const bf16_t*)(wl + W_BR), D, 4, 256, G, bx};
            Epi2 E{P_G0, P_G1, P_MG};
            pg8::gemm_phase<Epi2, SchedN>(lds, D, S, E);
            }
            SEAM(pb + 2);
        }
        if (PHON(4) && IN(pb + 3)) { for (int rep_ = 0; rep_ < (PROBE_REP == pb + 3 ? 2 : 1); ++rep_) {
            SchedN S{P_MG, (const bf16_t*)(wl + W_OUT), D, 4, 256, G, bx};
            Epi3 E{l == 0 ? x : (const float*)H, H};
            pg8::gemm_phase<Epi3, SchedN>(lds, D, S, E);
            }
            SEAM(pb + 3);
        }
        if (PHON(5) && IN(pb + 4)) { for (int rep_ = 0; rep_ < (PROBE_REP == pb + 4 ? 2 : 1); ++rep_) {
            int lane = threadIdx.x & 63; asm volatile("" : "+v"(lane));
            for (int m = gw; m < M; m += NGW) rms_row_bf16(H + (size_t)m * D, args.in[12] + l * D, P_XN + (size_t)m * D, lane);
            }
            SEAM(pb + 4);
        }
        if (PHON(6) && IN(pb + 5)) { for (int rep_ = 0; rep_ < (PROBE_REP == pb + 5 ? 2 : 1); ++rep_) {
            SchedN S{P_XN, (const bf16_t*)(wl + W_FI), D, 22, 128, G, bx};
            Epi4 E{P_ACT};
            pg8::gemm_phase<Epi4, SchedN>(lds, D, S, E);
            }
            SEAM(pb + 5);
        }
        if (PHON(7) && IN(pb + 6)) { for (int rep_ = 0; rep_ < (PROBE_REP == pb + 6 ? 2 : 1); ++rep_) {
            SchedN S{P_ACT, (const bf16_t*)(wl + W_FO), DFF, 4, 256, G, bx};
            Epi3 E{H, rep_ == 0 ? H : (float*)(ws + 184 * MiB)};
            pg8::gemm_phase<Epi3, SchedN>(lds, DFF, S, E);
            }
            SEAM(pb + 6);
        }
        if (PHON(8) && IN(pb + 7)) { for (int rep_ = 0; rep_ < (PROBE_REP == pb + 7 ? 2 : 1); ++rep_) {
            int lane = threadIdx.x & 63; asm volatile("" : "+v"(lane));
            if (l + 1 < DEPTH) { for (int m = gw; m < M; m += NGW) rms_row_bf16(H + (size_t)m * D, args.in[1] + (l + 1) * D, P_XN + (size_t)m * D, lane); if (rep_ + 1 == (PROBE_REP == pb + 7 ? 2 : 1)) SEAM(pb + 7); }
            else { for (int m = gw; m < M; m += NGW) rms_row_f32(H + (size_t)m * D, args.in[15], H + (size_t)m * D, lane); }
        } }
    }
    if (MK_LAUNCHES == 1) for (int i_ = 0; i_ < PROBE_BARS; ++i_) xcd_barrier(bar);
#undef IN
#undef SEAM
}

extern "C" void kernel_launch(void* const* d_in, const int* in_sizes, int n_in, void* d_out, int out_size, void* d_ws, size_t ws_size, hipStream_t stream) {
    static int grid = 0;
    if (grid == 0) {
        if (n_in != 16 || out_size != M * D || ws_size < WS_END) { fprintf(stderr, "kernel_launch: unexpected shapes (n_in %d, out %d, ws %zu)\n", n_in, out_size, ws_size); grid = -1; return; }
        int dev = 0, cus = 0, per_cu = 0;
        if (hipGetDevice(&dev) != hipSuccess || hipDeviceGetAttribute(&cus, hipDeviceAttributeMultiprocessorCount, dev) != hipSuccess) { grid = -1; return; }
        if (hipFuncSetAttribute((const void*)mega_fwd, hipFuncAttributeMaxDynamicSharedMemorySize, LDS_BYTES) != hipSuccess) { fprintf(stderr, "kernel_launch: hipFuncSetAttribute failed\n"); grid = -1; return; }
        if (hipOccupancyMaxActiveBlocksPerMultiprocessor(&per_cu, (const void*)mega_fwd, NTHREADS, LDS_BYTES) != hipSuccess || per_cu < 1) { fprintf(stderr, "kernel_launch: occupancy query says %d blocks per CU\n", per_cu); (void)hipGetLastError(); grid = -1; return; }
        grid = cus;
    }
    if (grid < 0) return;
    (void)hipMemsetAsync((char*)d_ws + WS_CTL, 0, CTL_ZERO_BYTES, stream);
    Args a{};
    for (int i = 0; i < 16; ++i) a.in[i] = (const float*)d_in[i];
    a.out = (float*)d_out; a.ws = (unsigned char*)d_ws;
    constexpr int NPH = 1 + 8 * DEPTH;
    if (MK_LAUNCHES == 1) { a.ph_lo = 0; a.ph_hi = NPH; hipLaunchKernelGGL(mega_fwd, dim3(grid), dim3(NTHREADS), LDS_BYTES, stream, a); }
    else for (int p = 0; p < NPH; ++p) { a.ph_lo = p; a.ph_hi = p + 1; hipLaunchKernelGGL(mega_fwd, dim3(grid), dim3(NTHREADS), LDS_BYTES, stream, a); }
}
```

```cpp
#include <hip/hip_runtime.h>
#include <cstdio>
#include <cstdint>

#ifndef MK_LAUNCHES
#define MK_LAUNCHES 1
#endif

#ifndef PROBE_REP
#define PROBE_REP (-1)
#endif
#ifndef PROBE_SUB
#define PROBE_SUB 0
#endif
#ifndef PROBE_BARS
#define PROBE_BARS 0
#endif

#define LAS __attribute__((address_space(3)))
#define GAS __attribute__((address_space(1)))
typedef unsigned short bf16_t;
typedef short bf16x8 __attribute__((ext_vector_type(8)));
typedef short s16x4 __attribute__((ext_vector_type(4)));
typedef float f32x2 __attribute__((ext_vector_type(2)));
typedef float f32x4 __attribute__((ext_vector_type(4)));
typedef float f32x16 __attribute__((ext_vector_type(16)));
typedef unsigned u32x2 __attribute__((ext_vector_type(2)));
typedef unsigned u32x4 __attribute__((ext_vector_type(4)));
typedef __bf16 bf16x2_t __attribute__((ext_vector_type(2)));
typedef _Float16 f16x2_t __attribute__((ext_vector_type(2)));

constexpr int M = 16384, D = 1024, SEQ = 4096, NBATCH = 4, DEPTH = 2;
constexpr int AW = 512, SW = 512, INW = 4608, DFF = 2816, NH = 8;
constexpr float EPS = 1e-6f;
constexpr float LOG2E = 1.4426950408889634f;
constexpr float QSCALE = 0.125f * LOG2E;
constexpr int NWAVES = 8, NTHREADS = 512;
constexpr int KP = 576;

constexpr size_t MiB = 1u << 20;
constexpr size_t WS_CTL = 0, CTL_ZERO_BYTES = 64 * 1024;
constexpr size_t WS_SSQ = 62 * MiB;
constexpr size_t WS_STATS = 1 * MiB;
constexpr size_t WS_SGWB = 1 * MiB + 512 * 1024;
constexpr size_t WS_R2 = 1 * MiB + 768 * 1024;
constexpr size_t WS_W = 2 * MiB, W_LAYER = 30 * MiB;
constexpr size_t W_IN = 0, W_BR = 9 * MiB, W_OUT = 11 * MiB, W_FI = 13 * MiB, W_FO = 24 * MiB;
constexpr size_t WS_XN = 64 * MiB;
constexpr size_t WS_Q = 96 * MiB, WS_K = 112 * MiB, WS_VT = 128 * MiB, WS_UG = 144 * MiB, WS_VGT = 162 * MiB, WS_G0 = 184 * MiB, WS_G1 = 216 * MiB;
constexpr size_t WS_MG = 96 * MiB;
constexpr size_t WS_ACT = 96 * MiB;
constexpr size_t WS_END = 248 * MiB;
constexpr int CW_BAR = 1024;

__device__ __forceinline__ unsigned pk_bf16(float lo, float hi) { f32x2 v = {lo, hi}; bf16x2_t b = __builtin_convertvector(v, bf16x2_t); return __builtin_bit_cast(unsigned, b); }
__device__ __forceinline__ unsigned pk_f16(float lo, float hi) { f32x2 v = {lo, hi}; f16x2_t b = __builtin_convertvector(v, f16x2_t); return __builtin_bit_cast(unsigned, b); }
__device__ __forceinline__ float bf_lo(unsigned w) { return __uint_as_float(w << 16); }
__device__ __forceinline__ float bf_hi(unsigned w) { return __uint_as_float(w & 0xffff0000u); }
__device__ __forceinline__ float h_lo(unsigned w) { f16x2_t h = __builtin_bit_cast(f16x2_t, w); return (float)h[0]; }
__device__ __forceinline__ float h_hi(unsigned w) { f16x2_t h = __builtin_bit_cast(f16x2_t, w); return (float)h[1]; }
__device__ __forceinline__ float fexp2(float x) { return __builtin_amdgcn_exp2f(x); }
__device__ __forceinline__ float frcp(float x) { return __builtin_amdgcn_rcpf(x); }
__device__ __forceinline__ float sigmoidf_(float z) { return frcp(1.f + fexp2(-LOG2E * z)); }
__device__ __forceinline__ float gelu_tanh(float x) { const float t = x * (1.f + 0.044715f * x * x) * (-2.302208198f); return x * frcp(1.f + fexp2(t)); }
__device__ __forceinline__ float wave_sum(float v) {
#pragma unroll
    for (int o = 1; o < 64; o <<= 1) v += __shfl_xor(v, o);
    return v;
}
__device__ __forceinline__ int crow(int r, int hi) { return (r & 3) + 8 * (r >> 2) + 4 * hi; }

namespace pg8 {
constexpr int BM = 256, BK = 64, HALF = 128, HTB = HALF * BK * 2, STAGE_BYTES = 8 * HTB;
__host__ __device__ __forceinline__ int lds_byte(int r, int c) { const int st = (r >> 4) * 2 + (c >> 5), rr = r & 15, cc = c & 31, ob = rr * 64 + cc * 2; return st * 1024 + (ob ^ (((ob >> 9) & 1) << 5)); }
__host__ __device__ __forceinline__ void stage_rc(int b, int& R, int& C) { const int st = b / 1024, sb = b % 1024, swz = sb ^ (((sb >> 9) & 1) << 5); R = (st >> 1) * 16 + swz / 64; C = (st & 1) * 32 + (swz % 64) / 2; }
__host__ __device__ __forceinline__ int perm32(int rho) { const int n = rho >> 4, i = rho & 15; return 8 * (i >> 2) + 4 * n + (i & 3); }

struct Unit { const char* A; const char* B; int kind, r0, c0; };

template <class Epi, class Sched>
__device__ __forceinline__ void gemm_phase(LAS unsigned char* lds, const int K, const Sched& S, const Epi& E) {
    int tid = threadIdx.x; asm volatile("" : "+v"(tid));
    const int wid = __builtin_amdgcn_readfirstlane(tid >> 6), lane = tid & 63, wr = wid >> 2, wc = wid & 3, fr = lane & 15, fq = lane >> 4;
    const int nt = K / BK;
    unsigned voffA[2], voffB[2];
#pragma unroll
    for (int i = 0; i < 2; ++i) { int R, C; stage_rc(tid * 16 + i * 8192, R, C); const int Rb = (R & ~31) + perm32(R & 31);
        voffA[i] = (unsigned)(R * K + C) * 2u; voffB[i] = (unsigned)(Rb * K + C) * 2u; }
    const size_t kstep = (size_t)(BK * 2);
    const size_t hstep = (size_t)HALF * K * 2;
    const unsigned ldsw = (unsigned)wid * 1024u;
    const int aoff = lds_byte(wr * 64 + fr, fq * 8), boff = lds_byte(wc * 32 + fr, fq * 8);
#define PG8_SA(b, h) (((b) * 2 + (h)) * HTB)
#define PG8_SB(b, h) ((4 + (b) * 2 + (h)) * HTB)
#define PG8_STAGE(bufoff, gbase, voff) do { _Pragma("unroll") for (int _i = 0; _i < 2; ++_i) \
        __builtin_amdgcn_global_load_lds((const unsigned*)((const char*)(gbase) + (voff)[_i]), (LAS unsigned*)(lds + (bufoff) + ldsw + _i * 8192), 16, 0, 0); } while (0)
#define PG8_LDA(dst, b, h) do { _Pragma("unroll") for (int m = 0; m < 4; ++m) _Pragma("unroll") for (int k = 0; k < 2; ++k) dst[m][k] = *(const LAS bf16x8*)(lds + PG8_SA(b, h) + aoff + m * 2048 + k * 1024); } while (0)
#define PG8_LDB(dst, b, h) do { _Pragma("unroll") for (int n = 0; n < 2; ++n) _Pragma("unroll") for (int k = 0; k < 2; ++k) dst[n][k] = *(const LAS bf16x8*)(lds + PG8_SB(b, h) + boff + n * 2048 + k * 1024); } while (0)
#define PG8_MMA(ai, bj, At, Bt) do { __builtin_amdgcn_s_setprio(1); _Pragma("unroll") for (int m = 0; m < 4; ++m) _Pragma("unroll") for (int n = 0; n < 2; ++n) _Pragma("unroll") for (int k = 0; k < 2; ++k) \
        acc[ai][bj][m][n] = __builtin_amdgcn_mfma_f32_16x16x32_bf16(Bt[n][k], At[m][k], acc[ai][bj][m][n], 0, 0, 0); __builtin_amdgcn_s_setprio(0); } while (0)
#define PG8_WAIT_V(n) asm volatile("s_waitcnt vmcnt(" #n ")" ::: "memory")
#define PG8_WAIT_L(n) asm volatile("s_waitcnt lgkmcnt(" #n ")" ::: "memory")
#define PG8_BAR __builtin_amdgcn_s_barrier()
#define PG8_SCHED __builtin_amdgcn_sched_barrier(0)
    Unit cur, nxt; int ui = 0;
    if (!S.next(0, cur)) return;
    f32x4 acc[2][2][4][2];
#pragma unroll
    for (int a = 0; a < 2; ++a)
#pragma unroll
        for (int b = 0; b < 2; ++b)
#pragma unroll
            for (int m = 0; m < 4; ++m)
#pragma unroll
                for (int n = 0; n < 2; ++n) acc[a][b][m][n] = (f32x4){0.f, 0.f, 0.f, 0.f};
    bf16x8 At[4][2], B0[2][2], B1[2][2];
    const char* cA = cur.A; const char* cB = cur.B;
    PG8_STAGE(PG8_SB(0, 0), cB, voffB); PG8_STAGE(PG8_SB(0, 1), cB + hstep, voffB); PG8_STAGE(PG8_SA(0, 0), cA, voffA); PG8_STAGE(PG8_SA(0, 1), cA + hstep, voffA);
    if (wr == 1) PG8_BAR;
    PG8_WAIT_V(2); PG8_BAR;
    PG8_STAGE(PG8_SB(1, 0), cB + kstep, voffB); PG8_STAGE(PG8_SA(1, 0), cA + kstep, voffA); PG8_STAGE(PG8_SB(1, 1), cB + hstep + kstep, voffB);
    PG8_WAIT_V(6); PG8_BAR;
    for (;;) {
        const bool has_next = S.next(ui + 1, nxt);
        const char* nA = has_next ? nxt.A : cA; const char* nB = has_next ? nxt.B : cB;
        for (int t = 0; t < nt; t += 2) {
            if (Epi::MID_T > 0 && t == Epi::MID_T) E.mid(acc, cur, wr, wc, fr, fq);
            const bool last = (t == nt - 2);
            const char* a1 = cA + (size_t)(t + 1) * kstep;
            const char* a2 = last ? nA : cA + (size_t)(t + 2) * kstep; const char* b2 = last ? nB : cB + (size_t)(t + 2) * kstep;
            const char* a3 = a2 + kstep; const char* b3 = b2 + kstep;
            PG8_LDB(B0, 0, 0); PG8_LDB(B1, 0, 1); PG8_SCHED; PG8_LDA(At, 0, 0); PG8_STAGE(PG8_SA(1, 1), a1 + hstep, voffA);
            PG8_WAIT_V(8); PG8_WAIT_L(0); PG8_BAR; PG8_MMA(0, 0, At, B0); PG8_MMA(0, 1, At, B1); PG8_BAR; PG8_SCHED;
            PG8_LDA(At, 0, 1); PG8_STAGE(PG8_SB(0, 0), b2, voffB); PG8_STAGE(PG8_SB(0, 1), b2 + hstep, voffB); PG8_STAGE(PG8_SA(0, 0), a2, voffA);
            PG8_WAIT_V(8); PG8_WAIT_L(0); PG8_BAR; PG8_MMA(1, 0, At, B0); PG8_MMA(1, 1, At, B1); PG8_BAR; PG8_SCHED;
            PG8_LDB(B0, 1, 0); PG8_LDB(B1, 1, 1); PG8_SCHED; PG8_LDA(At, 1, 0); PG8_STAGE(PG8_SA(0, 1), a2 + hstep, voffA);
            PG8_WAIT_V(8); PG8_WAIT_L(0); PG8_BAR; PG8_MMA(0, 0, At, B0); PG8_MMA(0, 1, At, B1); PG8_BAR; PG8_SCHED;
            PG8_LDA(At, 1, 1); PG8_STAGE(PG8_SB(1, 0), b3, voffB); PG8_STAGE(PG8_SB(1, 1), b3 + hstep, voffB); PG8_STAGE(PG8_SA(1, 0), a3, voffA);
            PG8_WAIT_V(8); PG8_WAIT_L(0); PG8_BAR; PG8_MMA(1, 0, At, B0); PG8_MMA(1, 1, At, B1); PG8_BAR; PG8_SCHED;
        }
        if (wr == 0) PG8_BAR;
        E(acc, cur, wr, wc, fr, fq);
        if (!has_next) break;
#pragma unroll
        for (int a = 0; a < 2; ++a)
#pragma unroll
            for (int b = 0; b < 2; ++b)
#pragma unroll
                for (int m = 0; m < 4; ++m)
#pragma unroll
                    for (int n = 0; n < 2; ++n) acc[a][b][m][n] = (f32x4){0.f, 0.f, 0.f, 0.f};
        cur = nxt; cA = nA; cB = nB; ++ui;
        if (wr == 1) PG8_BAR;
    }
    PG8_WAIT_V(0);
    PG8_BAR;
#undef PG8_SA
#undef PG8_SB
#undef PG8_STAGE
#undef PG8_LDA
#undef PG8_LDB
#undef PG8_MMA
#undef PG8_WAIT_V
#undef PG8_WAIT_L
#undef PG8_BAR
#undef PG8_SCHED
}
}
using pg8::Unit;

enum { K_Q = 0, K_K = 1, K_U = 2, K_G0 = 3, K_G1 = 4, K_VT = 5, K_VGT = 6 };

struct Epi1 {
    static constexpr int MID_T = 0;
    unsigned char* ws; const float* bgate; const LAS float* rs; int tok_base;
    __device__ __forceinline__ void mid(f32x4 (&)[2][2][4][2], const Unit&, int, int, int, int) const {}
    __device__ __forceinline__ void operator()(const f32x4 (&acc)[2][2][4][2], const Unit& u, int wr, int wc, int fr, int fq) const {
        const int kind = u.kind;
        int rowb = u.r0 + wr * 64 + fr, colb = u.c0 + wc * 32 + 8 * fq;
        asm volatile("" : "+v"(rowb), "+v"(colb));
        if (kind == K_Q || kind == K_K || kind == K_U) {
            bf16_t* O = (bf16_t*)(ws + (kind == K_Q ? WS_Q : (kind == K_K ? WS_K : WS_UG)));
            const float sc = kind == K_Q ? QSCALE : 1.f;
#pragma unroll
            for (int ai = 0; ai < 2; ++ai)
#pragma unroll
                for (int m = 0; m < 4; ++m) { const int tok = rowb + ai * 128 + m * 16; const float rsv = rs[tok - tok_base];
#pragma unroll
                    for (int bj = 0; bj < 2; ++bj) { f32x4 v0 = acc[ai][bj][m][0] * rsv, v1 = acc[ai][bj][m][1] * rsv; const int col = colb + bj * 128;
                        bf16_t* dst = kind == K_U ? O + (unsigned)(tok * KP + col) : O + (unsigned)((((tok >> 5) * 8 + (col >> 6)) * 4 + ((col >> 4) & 3)) * 512 + ((col >> 3) & 1) * 256 + (tok & 31) * 8);
                        if (kind == K_U) {
#pragma unroll
                            for (int e = 0; e < 4; ++e) { v0[e] = gelu_tanh(v0[e]); v1[e] = gelu_tanh(v1[e]); } }
                        else { v0 = v0 * sc; v1 = v1 * sc; }
                        u32x4 w; w.x = pk_bf16(v0[0], v0[1]); w.y = pk_bf16(v0[2], v0[3]); w.z = pk_bf16(v1[0], v1[1]); w.w = pk_bf16(v1[2], v1[3]);
                        *(u32x4*)dst = w; } }
        } else if (kind == K_G0 || kind == K_G1) {
            unsigned short* O = (unsigned short*)(ws + (kind == K_G0 ? WS_G0 : WS_G1)); const float* bg = bgate + (kind == K_G0 ? 0 : D);
#pragma unroll
            for (int bj = 0; bj < 2; ++bj) { const f32x4 bv0 = *(const f32x4*)(bg + colb + bj * 128), bv1 = *(const f32x4*)(bg + colb + bj * 128 + 4);
#pragma unroll
                for (int ai = 0; ai < 2; ++ai)
#pragma unroll
                    for (int m = 0; m < 4; ++m) { const float rsv = rs[rowb + ai * 128 + m * 16 - tok_base]; f32x4 v0 = acc[ai][bj][m][0] * rsv + bv0, v1 = acc[ai][bj][m][1] * rsv + bv1;
#pragma unroll
                        for (int e = 0; e < 4; ++e) { v0[e] = sigmoidf_(v0[e]); v1[e] = sigmoidf_(v1[e]); }
                        u32x4 w; w.x = pk_f16(v0[0], v0[1]); w.y = pk_f16(v0[2], v0[3]); w.z = pk_f16(v1[0], v1[1]); w.w = pk_f16(v1[2], v1[3]);
                        *(u32x4*)(O + (unsigned)((rowb + ai * 128 + m * 16) * 1024 + colb + bj * 128)) = w; } }
        } else if (kind == K_VT) {
            bf16_t* VT = (bf16_t*)(ws + WS_VT);
#pragma unroll
            for (int ai = 0; ai < 2; ++ai)
#pragma unroll
                for (int m = 0; m < 4; ++m) { const int ch = rowb + ai * 128 + m * 16, hd = ch >> 6, dd = ch & 63;
#pragma unroll
                    for (int bj = 0; bj < 2; ++bj) { const int t8 = colb + bj * 128; const LAS f32x4* rp = (const LAS f32x4*)(rs + (t8 - tok_base));
                        const f32x4 v0 = acc[ai][bj][m][0] * rp[0], v1 = acc[ai][bj][m][1] * rp[1];
                        const unsigned f = (unsigned)(((((t8 >> 6) * 8 + hd) * 2 + (dd >> 5)) * 2 + ((t8 >> 5) & 1)) * 2 + ((t8 >> 4) & 1));
                        bf16_t* dst = VT + f * 512 + (dd & 31) * 8 + 4 * ((t8 >> 3) & 1);
                        u32x2 w0, w1; w0.x = pk_bf16(v0[0], v0[1]); w0.y = pk_bf16(v0[2], v0[3]); w1.x = pk_bf16(v1[0], v1[1]); w1.y = pk_bf16(v1[2], v1[3]);
                        *(u32x2*)dst = w0; *(u32x2*)(dst + 256) = w1; } }
        } else {
            bf16_t* VGT = (bf16_t*)(ws + WS_VGT); f32x2* stats = (f32x2*)(ws + WS_STATS);
            const int slot = (u.r0 >> 8) * 2 + wr;
#pragma unroll
            for (int bj = 0; bj < 2; ++bj)
#pragma unroll
                for (int n = 0; n < 2; ++n) {
                    f32x4 s0 = (f32x4){0.f, 0.f, 0.f, 0.f}, q0 = s0; const int t4 = colb + bj * 128 + 4 * n;
                    const f32x4 rs4 = *(const LAS f32x4*)(rs + (t4 - tok_base));
#pragma unroll
                    for (int ai = 0; ai < 2; ++ai)
#pragma unroll
                        for (int m = 0; m < 4; ++m) { f32x4 v0 = acc[ai][bj][m][n] * rs4; const int ch = rowb + ai * 128 + m * 16;
#pragma unroll
                            for (int e = 0; e < 4; ++e) v0[e] = gelu_tanh(v0[e]);
                            s0 += v0; q0 += v0 * v0;
                            u32x2 w; w.x = pk_bf16(v0[0], v0[1]); w.y = pk_bf16(v0[2], v0[3]);
                            *(u32x2*)(VGT + (unsigned)(((t4 >> 4) * 16 + (ch >> 5)) * 512 + ((t4 >> 3) & 1) * 256 + (ch & 31) * 8 + (t4 & 4))) = w; }
#pragma unroll
                    for (int e = 0; e < 4; ++e) { float a = s0[e], b = q0[e];
#pragma unroll
                        for (int o = 1; o < 16; o <<= 1) { a += __shfl_xor(a, o); b += __shfl_xor(b, o); }
                        if (fr == 0) stats[(size_t)(t4 + e) * 4 + slot] = (f32x2){a, b}; }
                    asm volatile("" ::: "memory");
                }
        }
    }
};

struct Epi2 {
    static constexpr int MID_T = 8;
    const unsigned short *G0, *G1; bf16_t* MG;
    __device__ __forceinline__ void mid(f32x4 (&acc)[2][2][4][2], const Unit& u, int wr, int wc, int fr, int fq) const {
        int rowb = u.r0 + wr * 64 + fr, colb = u.c0 + wc * 32 + 8 * fq;
        asm volatile("" : "+v"(rowb), "+v"(colb));
#pragma unroll
        for (int ai = 0; ai < 2; ++ai) {
            u32x4 a[4][2], b[4][2];
#pragma unroll
            for (int m = 0; m < 4; ++m)
#pragma unroll
                for (int bj = 0; bj < 2; ++bj) { const unsigned off = (unsigned)((rowb + ai * 128 + m * 16) * 1024 + colb + bj * 128); a[m][bj] = *(const u32x4*)(G0 + off); b[m][bj] = *(const u32x4*)(G1 + off); }
#pragma unroll
            for (int m = 0; m < 4; ++m)
#pragma unroll
                for (int bj = 0; bj < 2; ++bj) { const u32x4 aa = a[m][bj], bb = b[m][bj]; f32x4 r0, r1;
                    r0[0] = h_lo(aa.x) * frcp(h_lo(bb.x)); r0[1] = h_hi(aa.x) * frcp(h_hi(bb.x)); r0[2] = h_lo(aa.y) * frcp(h_lo(bb.y)); r0[3] = h_hi(aa.y) * frcp(h_hi(bb.y));
                    r1[0] = h_lo(aa.z) * frcp(h_lo(bb.z)); r1[1] = h_hi(aa.z) * frcp(h_hi(bb.z)); r1[2] = h_lo(aa.w) * frcp(h_lo(bb.w)); r1[3] = h_hi(aa.w) * frcp(h_hi(bb.w));
                    acc[ai][bj][m][0] *= r0; acc[ai][bj][m][1] *= r1; }
            asm volatile("" ::: "memory");
        }
    }
    __device__ __forceinline__ void operator()(const f32x4 (&acc)[2][2][4][2], const Unit& u, int wr, int wc, int fr, int fq) const {
        const int rowb = u.r0 + wr * 64 + fr, colb = u.c0 + wc * 32 + 8 * fq;
#pragma unroll
        for (int ai = 0; ai < 2; ++ai) {
            u32x4 b[4][2];
#pragma unroll
            for (int m = 0; m < 4; ++m)
#pragma unroll
                for (int bj = 0; bj < 2; ++bj) b[m][bj] = *(const u32x4*)(G1 + (unsigned)((rowb + ai * 128 + m * 16) * 1024 + colb + bj * 128));
#pragma unroll
            for (int m = 0; m < 4; ++m)
#pragma unroll
                for (int bj = 0; bj < 2; ++bj) { const u32x4 bb = b[m][bj]; const f32x4 v0 = acc[ai][bj][m][0], v1 = acc[ai][bj][m][1];
                    u32x4 w; w.x = pk_bf16(v0[0] * h_lo(bb.x), v0[1] * h_hi(bb.x)); w.y = pk_bf16(v0[2] * h_lo(bb.y), v0[3] * h_hi(bb.y));
                    w.z = pk_bf16(v1[0] * h_lo(bb.z), v1[1] * h_hi(bb.z)); w.w = pk_bf16(v1[2] * h_lo(bb.w), v1[3] * h_hi(bb.w));
                    *(u32x4*)(MG + (unsigned)((rowb + ai * 128 + m * 16) * 1024 + colb + bj * 128)) = w; }
            asm volatile("" ::: "memory");
        }
    }
};

struct Epi3 {
    static constexpr int MID_T = 0;
    bf16_t* hb; float* ssq;
    __device__ __forceinline__ void mid(f32x4 (&)[2][2][4][2], const Unit&, int, int, int, int) const {}
    __device__ __forceinline__ void operator()(const f32x4 (&acc)[2][2][4][2], const Unit& u, int wr, int wc, int fr, int fq) const {
        const int rowb = u.r0 + wr * 64 + fr, colb = u.c0 + wc * 32 + 8 * fq, slot = (u.c0 >> 8) * 4 + wc;
        u32x4 bs[2][4][2];
#pragma unroll
        for (int ai = 0; ai < 2; ++ai)
#pragma unroll
            for (int m = 0; m < 4; ++m)
#pragma unroll
                for (int bj = 0; bj < 2; ++bj) bs[ai][m][bj] = *(const u32x4*)(hb + (unsigned)((rowb + ai * 128 + m * 16) * D + colb + bj * 128));
#pragma unroll
        for (int ai = 0; ai < 2; ++ai)
#pragma unroll
            for (int m = 0; m < 4; ++m) { const int row = rowb + ai * 128 + m * 16; float q = 0.f;
#pragma unroll
                for (int bj = 0; bj < 2; ++bj) { const u32x4 b = bs[ai][m][bj]; const f32x4 a0 = acc[ai][bj][m][0], a1 = acc[ai][bj][m][1];
                    const float h0 = bf_lo(b.x) + a0[0], h1 = bf_hi(b.x) + a0[1], h2 = bf_lo(b.y) + a0[2], h3 = bf_hi(b.y) + a0[3], h4 = bf_lo(b.z) + a1[0], h5 = bf_hi(b.z) + a1[1], h6 = bf_lo(b.w) + a1[2], h7 = bf_hi(b.w) + a1[3];
                    q += (h0 * h0 + h1 * h1) + (h2 * h2 + h3 * h3) + (h4 * h4 + h5 * h5) + (h6 * h6 + h7 * h7);
                    u32x4 w; w.x = pk_bf16(h0, h1); w.y = pk_bf16(h2, h3); w.z = pk_bf16(h4, h5); w.w = pk_bf16(h6, h7);
                    *(u32x4*)(hb + (unsigned)(row * D + colb + bj * 128)) = w; }
                q += __shfl_xor(q, 16); q += __shfl_xor(q, 32);
                if (fq == 0) ssq[(size_t)row * 16 + slot] = q; }
    }
};

struct Epi4 {
    static constexpr int MID_T = 0;
    bf16_t* ACT; const LAS float* rs; int tok_base;
    __device__ __forceinline__ void mid(f32x4 (&)[2][2][4][2], const Unit&, int, int, int, int) const {}
    __device__ __forceinline__ void operator()(const f32x4 (&acc)[2][2][4][2], const Unit& u, int wr, int wc, int fr, int fq) const {
        const int rowb = u.r0 + wr * 64 + fr, colb = u.c0 + wc * 32 + 8 * fq;
#pragma unroll
        for (int ai = 0; ai < 2; ++ai)
#pragma unroll
            for (int m = 0; m < 4; ++m) { const float rsv = rs[rowb + ai * 128 + m * 16 - tok_base];
                const f32x4 g0 = acc[ai][0][m][0] * rsv, g1 = acc[ai][0][m][1] * rsv, u0 = acc[ai][1][m][0] * rsv, u1 = acc[ai][1][m][1] * rsv; f32x4 v0, v1;
#pragma unroll
                for (int e = 0; e < 4; ++e) { v0[e] = g0[e] * sigmoidf_(g0[e]) * u0[e]; v1[e] = g1[e] * sigmoidf_(g1[e]) * u1[e]; }
                u32x4 w; w.x = pk_bf16(v0[0], v0[1]); w.y = pk_bf16(v0[2], v0[3]); w.z = pk_bf16(v1[0], v1[1]); w.w = pk_bf16(v1[2], v1[3]);
                *(u32x4*)(ACT + (size_t)(rowb + ai * 128 + m * 16) * DFF + colb) = w; }
    }
};

struct Sched1 {
    const bf16_t* XN; const bf16_t* WT; int G, c;
    __device__ __forceinline__ bool next(int i, Unit& u) const {
        const int L = i * G + c; if (L >= 1152) return false;
        const int x = L & 7, off = L >> 3;
        if (off < 112) { const int pm = 8 * x + (off & 7), t = off >> 3;
            const int wt = t < 4 ? t : (t < 6 ? t + 2 : t + 4);
            u.A = (const char*)(XN + (size_t)pm * 256 * D); u.B = (const char*)(WT + (size_t)wt * 256 * D); u.r0 = pm * 256;
            if (t < 2) { u.kind = K_Q; u.c0 = t * 256; } else if (t < 4) { u.kind = K_K; u.c0 = (t - 2) * 256; } else if (t < 6) { u.kind = K_U; u.c0 = (t - 4) * 256; }
            else if (t < 10) { u.kind = K_G0; u.c0 = (t - 6) * 256; } else { u.kind = K_G1; u.c0 = (t - 10) * 256; }
        } else { const int o2 = off - 112, pn = 8 * x + (o2 & 7), w = o2 >> 3;
            const int wt = w < 2 ? 4 + w : 6 + w;
            u.A = (const char*)(WT + (size_t)wt * 256 * D); u.B = (const char*)(XN + (size_t)pn * 256 * D);
            u.kind = w < 2 ? K_VT : K_VGT; u.r0 = (w & 1) * 256; u.c0 = pn * 256; }
        return true;
    }
};
struct SchedN {
    const bf16_t* A; const bf16_t* Bt; int K, nN, cw, G, c;
    __device__ __forceinline__ bool next(int i, Unit& u) const {
        const int L = i * G + c; if (L >= 64 * nN) return false;
        const int x = L & 7, off = L >> 3, pm = 8 * x + (off & 7), pn = off >> 3;
        u.A = (const char*)(A + (size_t)pm * 256 * K); u.B = (const char*)(Bt + (size_t)pn * 256 * K); u.kind = 0; u.r0 = pm * 256; u.c0 = pn * cw; return true;
    }
};

#define XB_TMO      128
#define XB_XCNT(j)  (256  + 64 * (j))
#define XB_XSUB(j)  (1280 + 64 * (j))
#define XB_XGEN(j)  (2304 + 64 * (j))
#define XB_TOP      3328
#define XB_TOPGEN   3392
#define XCD_BAR_WORDS 3456
#define XB_SPIN_CAP (1u << 18)
__device__ __forceinline__ unsigned xb_ld(unsigned* p)              { return __hip_atomic_load(p, __ATOMIC_RELAXED, __HIP_MEMORY_SCOPE_AGENT); }
__device__ __forceinline__ unsigned xb_add(unsigned* p, unsigned v) { return __hip_atomic_fetch_add(p, v, __ATOMIC_RELAXED, __HIP_MEMORY_SCOPE_AGENT); }
__device__ __forceinline__ unsigned xb_xcc_id() { return (unsigned)__builtin_amdgcn_s_getreg((3 << 11) | 20) & 0xFu; }
#define XB_SPIN(cond, bar) do { unsigned _sp = 0; while (cond) { __builtin_amdgcn_s_sleep(1); \
    if ((++_sp & 255u) == 0u) { if (xb_ld(&(bar)[XB_TMO])) break; if (_sp > XB_SPIN_CAP) { atomicAdd(&(bar)[XB_TMO], 1u); break; } } } } while (0)
struct XcdBarrier { unsigned* bar; unsigned x; volatile LAS unsigned* st; };
__device__ __forceinline__ XcdBarrier xcd_barrier_post(unsigned* bar, volatile LAS unsigned* st) {
    XcdBarrier b; b.bar = bar; b.x = xb_xcc_id(); b.st = st;
    if (threadIdx.x == 0) (void)xb_add(&bar[XB_XCNT(b.x)], 1u);
    return b;
}
__device__ __forceinline__ void xcd_barrier_complete(unsigned* bar, unsigned x, unsigned& nloc, unsigned& nx) {
    const unsigned G = gridDim.x * gridDim.y * gridDim.z;
    unsigned sum, cnt, mine, sp = 0u;
    for (;;) {
        sum = 0u; cnt = 0u; mine = 0u;
#pragma unroll
        for (unsigned j = 0; j < 16; ++j) { const unsigned c = xb_ld(&bar[XB_XCNT(j)]); sum += c; cnt += (c > 0u) ? 1u : 0u; mine = (j == x) ? c : mine; }
        if (sum == G) break;
        __builtin_amdgcn_s_sleep(1);
        if ((++sp & 255u) == 0u) { if (xb_ld(&bar[XB_TMO])) break; if (sp > XB_SPIN_CAP) { atomicAdd(&bar[XB_TMO], 1u); break; } }
    }
    nloc = mine > 0u ? mine : 1u; nx = cnt > 0u ? cnt : 1u;
}
__device__ __forceinline__ void xcd_barrier(const XcdBarrier& b) {
    asm volatile("s_waitcnt vmcnt(0)" ::: "memory");
    __syncthreads();
    if (threadIdx.x == 0) {
        unsigned* bar = b.bar;
        __builtin_amdgcn_s_waitcnt(0);
        unsigned nloc = b.st[0], nx = b.st[1];
        if (nloc == 0u) { xcd_barrier_complete(bar, b.x, nloc, nx); b.st[0] = nloc; b.st[1] = nx; }
        const unsigned old = xb_add(&bar[XB_XSUB(b.x)], 1u);
        const unsigned gen = old / nloc;
        if (old + 1u == (gen + 1u) * nloc) {
            __builtin_amdgcn_fence(__ATOMIC_RELEASE, "agent");
            asm volatile("s_waitcnt vmcnt(0)" ::: "memory");
            const unsigned og = xb_add(&bar[XB_TOP], 1u);
            const unsigned tg = og / nx;
            if (og + 1u == (tg + 1u) * nx) xb_add(&bar[XB_TOPGEN], 1u);
            else XB_SPIN(xb_ld(&bar[XB_TOPGEN]) == tg, bar);
            __builtin_amdgcn_fence(__ATOMIC_ACQUIRE, "agent");
            xb_add(&bar[XB_XGEN(b.x)], 1u);
            asm volatile("s_waitcnt vmcnt(0)" ::: "memory");
        } else {
            XB_SPIN(xb_ld(&bar[XB_XGEN(b.x)]) == gen, bar);
            __builtin_amdgcn_fence(__ATOMIC_ACQUIRE, "agent");
            asm volatile("s_waitcnt vmcnt(0)" ::: "memory");
        }
    }
    __syncthreads();
}

struct Args { const float* in[16]; float* out; unsigned char* ws; int ph_lo, ph_hi; };

__device__ __forceinline__ void transpose_item(const float* W, int N, bf16_t* WT, int ldk, int koff, int k0, int n0, int drow0, LAS float* scr, int lane, const float* gain = nullptr) {
#pragma unroll 8
    for (int i = 0; i < 32; ++i) { const int kk = 2 * i + (lane >> 5); const float gk = gain ? gain[k0 + kk] : 1.f; scr[kk * 33 + (lane & 31)] = W[(size_t)(k0 + kk) * N + n0 + (lane & 31)] * gk; }
    asm volatile("s_waitcnt lgkmcnt(0)" ::: "memory");
    const int c = lane & 7;
#pragma unroll
    for (int j = 0; j < 4; ++j) { const int n = (lane >> 3) + 8 * j; const LAS float* s = scr + (8 * c) * 33 + n;
        u32x4 o; o.x = pk_bf16(s[0 * 33], s[1 * 33]); o.y = pk_bf16(s[2 * 33], s[3 * 33]); o.z = pk_bf16(s[4 * 33], s[5 * 33]); o.w = pk_bf16(s[6 * 33], s[7 * 33]);
        *(u32x4*)(WT + (size_t)(drow0 + n) * ldk + koff + k0 + 8 * c) = o; }
    asm volatile("s_waitcnt lgkmcnt(0)" ::: "memory");
}
__device__ __forceinline__ void rms_row_bf16(const float* xrow, const float* g, bf16_t* orow, int lane) {
    const f32x4* xr = (const f32x4*)xrow + lane; const f32x4* gr = (const f32x4*)g + lane;
    f32x4 v[4]; float s = 0.f;
#pragma unroll
    for (int j = 0; j < 4; ++j) { v[j] = xr[64 * j]; s += (v[j].x * v[j].x + v[j].y * v[j].y) + (v[j].z * v[j].z + v[j].w * v[j].w); }
    const float r = 1.0f / sqrtf(wave_sum(s) * (1.f / D) + EPS);
    u32x2* o8 = (u32x2*)orow + lane;
#pragma unroll
    for (int j = 0; j < 4; ++j) { const f32x4 q = gr[64 * j]; u32x2 w; w.x = pk_bf16(v[j].x * r * q.x, v[j].y * r * q.y); w.y = pk_bf16(v[j].z * r * q.z, v[j].w * r * q.w); o8[64 * j] = w; }
}
__device__ __forceinline__ void copy_row_bf16_ssq(const float* xrow, bf16_t* orow, float* ssqrow, int lane) {
    const f32x4* xr = (const f32x4*)xrow + lane; f32x4 v[4]; float s = 0.f;
#pragma unroll
    for (int j = 0; j < 4; ++j) { v[j] = xr[64 * j]; s += (v[j].x * v[j].x + v[j].y * v[j].y) + (v[j].z * v[j].z + v[j].w * v[j].w); }
    s = wave_sum(s);
    u32x2* o8 = (u32x2*)orow + lane;
#pragma unroll
    for (int j = 0; j < 4; ++j) { u32x2 w; w.x = pk_bf16(v[j].x, v[j].y); w.y = pk_bf16(v[j].z, v[j].w); o8[64 * j] = w; }
    if (lane < 16) ssqrow[lane] = lane == 0 ? s : 0.f;
}
__device__ __forceinline__ void load_rstd(LAS float* tab, const float* ssq, int x, int tid) {
#pragma unroll
    for (int j = 0; j < 4; ++j) { const int t = 512 * j + tid; const f32x4* p = (const f32x4*)(ssq + (size_t)(2048 * x + t) * 16);
        const f32x4 a = (p[0] + p[1]) + (p[2] + p[3]); const float sq = (a[0] + a[1]) + (a[2] + a[3]);
        tab[t] = 1.0f / sqrtf(sq * (1.f / D) + EPS); }
    __syncthreads();
}
__device__ __forceinline__ void final_row(const bf16_t* hrow, const float* ssqrow, const float* g, float* orow, int lane) {
    const f32x4* sp = (const f32x4*)ssqrow; const f32x4 a = (sp[0] + sp[1]) + (sp[2] + sp[3]); const float r = 1.0f / sqrtf(((a[0] + a[1]) + (a[2] + a[3])) * (1.f / D) + EPS);
    const u32x4* hr = (const u32x4*)hrow + lane; const f32x4* gr = (const f32x4*)g; f32x4* o = (f32x4*)orow;
#pragma unroll
    for (int j = 0; j < 2; ++j) { const u32x4 w = hr[64 * j]; const f32x4 g0 = gr[(64 * j + lane) * 2], g1 = gr[(64 * j + lane) * 2 + 1];
        o[(64 * j + lane) * 2] = (f32x4){bf_lo(w.x), bf_hi(w.x), bf_lo(w.y), bf_hi(w.y)} * r * g0; o[(64 * j + lane) * 2 + 1] = (f32x4){bf_lo(w.z), bf_hi(w.z), bf_lo(w.w), bf_hi(w.w)} * r * g1; }
}
__device__ __forceinline__ void rms_row_f32(const float* xrow, const float* g, float* orow, int lane) {
    const f32x4* xr = (const f32x4*)xrow + lane; const f32x4* gr = (const f32x4*)g + lane;
    f32x4 v[4]; float s = 0.f;
#pragma unroll
    for (int j = 0; j < 4; ++j) { v[j] = xr[64 * j]; s += (v[j].x * v[j].x + v[j].y * v[j].y) + (v[j].z * v[j].z + v[j].w * v[j].w); }
    const float r = 1.0f / sqrtf(wave_sum(s) * (1.f / D) + EPS);
    f32x4* o = (f32x4*)orow + lane;
#pragma unroll
    for (int j = 0; j < 4; ++j) { const f32x4 q = gr[64 * j]; o[64 * j] = v[j] * r * q; }
}

constexpr float ATT_THR = 6.0f;
constexpr int TABN = 320, TAB_BYTES = 4 * TABN * 4;
__device__ __forceinline__ float halfmax(float m) { auto rr = __builtin_amdgcn_permlane32_swap(__float_as_uint(m), __float_as_uint(m), false, false); return fmaxf(__uint_as_float(rr[0]), __uint_as_float(rr[1])); }
#define MX3(a, b, c) __builtin_fmaxf(__builtin_fmaxf((a), (b)), (c))
template <int VAR> __device__ __forceinline__ void attn_unit(int b, int c, const bf16_t* Q, const bf16_t* Kb, const bf16_t* VT, bf16_t* AS, const float* relb, LAS float* tab, LAS unsigned char* qlds, int wid, int lane) {
    const int r32 = lane & 31, hi = lane >> 5;
    const int t0 = b * SEQ + 64 * c;
    const int kt0 = c >= 8 ? 0 : 8 - c;
    const bf16_t* kptr = Kb + ((ptrdiff_t)((t0 - 512) >> 5) * 8 + wid) * 2048 + lane * 8;
    const bf16_t* vptr = VT + ((ptrdiff_t)((t0 - 512) >> 6) * 8 + wid) * 4096 + lane * 8;
    bf16x8 kf[2][4];
#pragma unroll
    for (int kh = 0; kh < 2; ++kh)
#pragma unroll
        for (int d0 = 0; d0 < 4; ++d0) kf[kh][d0] = *(const bf16x8*)(kptr + (2 * kt0 + kh) * 16384 + d0 * 512);
    for (int i = lane; i < 4 * TABN; i += 64) { const int cc = i / TABN, k = i - cc * TABN; int e = 319 - (k + cc); e = e < 0 ? 0 : (e > 256 ? 256 : e); tab[i] = relb[wid * 257 + e] * LOG2E; }
    const float c256 = relb[wid * 257 + 256] * LOG2E;
#pragma unroll
    for (int qb = 0; qb < 2; ++qb)
#pragma unroll
        for (int d0 = 0; d0 < 4; ++d0) *(LAS bf16x8*)(qlds + (qb * 4 + d0) * 1024 + lane * 16) = *(const bf16x8*)(Q + ((size_t)((t0 >> 5) + qb) * 8 + wid) * 2048 + d0 * 512 + lane * 8);
    f32x16 o[2][2];
#pragma unroll
    for (int db = 0; db < 2; ++db)
#pragma unroll
        for (int qb = 0; qb < 2; ++qb)
#pragma unroll
            for (int r = 0; r < 16; ++r) o[db][qb][r] = 0.f;
    float mref[2] = {-1e30f, -1e30f}, lrun[2] = {0.f, 0.f};
    for (int kt = kt0; kt < 9; ++kt) {
        bf16x8 vf[2][2][2];
#pragma unroll
        for (int db = 0; db < 2; ++db)
#pragma unroll
            for (int kh = 0; kh < 2; ++kh)
#pragma unroll
                for (int s = 0; s < 2; ++s) vf[db][kh][s] = *(const bf16x8*)(vptr + ((VAR & 1) ? kt0 : kt) * 32768 + ((db * 2 + kh) * 2 + s) * 512);
        u32x4 pk[2][2][2];
        LAS unsigned char* qp = qlds + lane * 16; asm volatile("" : "+v"(qp));
#pragma unroll
        for (int qb = 0; qb < 2; ++qb) {
            f32x16 p0, p1; float cadd;
            if (kt < 6) { cadd = c256;
                const f32x16 z = {0.f, 0.f, 0.f, 0.f, 0.f, 0.f, 0.f, 0.f, 0.f, 0.f, 0.f, 0.f, 0.f, 0.f, 0.f, 0.f};
                { const bf16x8 qfr = *(const LAS bf16x8*)(qp + (qb * 4) * 1024);
                  p0 = __builtin_amdgcn_mfma_f32_32x32x16_bf16(kf[0][0], qfr, z, 0, 0, 0); p1 = __builtin_amdgcn_mfma_f32_32x32x16_bf16(kf[1][0], qfr, z, 0, 0, 0); }
#pragma unroll
                for (int d0 = 1; d0 < 4; ++d0) { const bf16x8 qfr = *(const LAS bf16x8*)(qp + (qb * 4 + d0) * 1024);
                    p0 = __builtin_amdgcn_mfma_f32_32x32x16_bf16(kf[0][d0], qfr, p0, 0, 0, 0); p1 = __builtin_amdgcn_mfma_f32_32x32x16_bf16(kf[1][d0], qfr, p1, 0, 0, 0); }
            } else { cadd = 0.f;
                const int a0 = 319 - (640 + 32 * qb + r32 - 64 * kt - 4 * hi), sh = a0 & 3;
                const LAS f32x4* tp = (const LAS f32x4*)(tab + sh * TABN + (a0 & ~3));
#pragma unroll
                for (int g4 = 0; g4 < 4; ++g4) { const f32x4 v0 = tp[2 * g4], v1 = tp[2 * g4 + 8];
#pragma unroll
                    for (int e = 0; e < 4; ++e) { p0[4 * g4 + e] = v0[e]; p1[4 * g4 + e] = v1[e]; } }
#pragma unroll
                for (int d0 = 0; d0 < 4; ++d0) { const bf16x8 qfr = *(const LAS bf16x8*)(qp + (qb * 4 + d0) * 1024);
                    p0 = __builtin_amdgcn_mfma_f32_32x32x16_bf16(kf[0][d0], qfr, p0, 0, 0, 0); p1 = __builtin_amdgcn_mfma_f32_32x32x16_bf16(kf[1][d0], qfr, p1, 0, 0, 0); }
            }
            if (qb == 1) {
                const int ktn = (VAR & 1) ? kt0 : (kt < 8 ? kt + 1 : 8);
                __builtin_amdgcn_sched_barrier(0);
#pragma unroll
                for (int kh = 0; kh < 2; ++kh)
#pragma unroll
                    for (int d0 = 0; d0 < 4; ++d0) kf[kh][d0] = *(const bf16x8*)(kptr + (2 * ktn + kh) * 16384 + d0 * 512);
                __builtin_amdgcn_sched_barrier(0);
            }
            float ma = MX3(p0[0], p0[1], p1[0]), mb = MX3(p0[2], p0[3], p1[1]); ma = MX3(ma, p1[2], p1[3]);
#pragma unroll
            for (int r = 4; r < 16; r += 4) { ma = MX3(ma, p0[r], p0[r + 1]); mb = MX3(mb, p0[r + 2], p0[r + 3]); ma = MX3(ma, p1[r], p1[r + 1]); mb = MX3(mb, p1[r + 2], p1[r + 3]); }
            const float mx = halfmax(fmaxf(ma, mb)) + cadd;
            if (__any(mx - mref[qb] > ATT_THR)) {
                const float nref = (mx - mref[qb] > ATT_THR) ? mx : mref[qb], alpha = fexp2(mref[qb] - nref);
                mref[qb] = nref; lrun[qb] *= alpha;
#pragma unroll
                for (int r = 0; r < 16; ++r) { o[0][qb][r] *= alpha; o[1][qb][r] *= alpha; }
            }
            const float sub = mref[qb] - cadd;
            float rs0 = 0.f, rs1 = 0.f;
#pragma unroll
            for (int r = 0; r < 16; ++r) { if (VAR & 2) { p0[r] = p0[r] - sub; p1[r] = p1[r] - sub; } else { p0[r] = fexp2(p0[r] - sub); p1[r] = fexp2(p1[r] - sub); } rs0 += p0[r]; rs1 += p1[r]; }
            lrun[qb] += rs0 + rs1;
#pragma unroll
            for (int s = 0; s < 2; ++s) {
                pk[qb][0][s] = (u32x4){pk_bf16(p0[8 * s], p0[8 * s + 1]), pk_bf16(p0[8 * s + 2], p0[8 * s + 3]), pk_bf16(p0[8 * s + 4], p0[8 * s + 5]), pk_bf16(p0[8 * s + 6], p0[8 * s + 7])};
                pk[qb][1][s] = (u32x4){pk_bf16(p1[8 * s], p1[8 * s + 1]), pk_bf16(p1[8 * s + 2], p1[8 * s + 3]), pk_bf16(p1[8 * s + 4], p1[8 * s + 5]), pk_bf16(p1[8 * s + 6], p1[8 * s + 7])};
            }
        }
#pragma unroll
        for (int db = 0; db < 2; ++db)
#pragma unroll
            for (int qb = 0; qb < 2; ++qb)
#pragma unroll
                for (int kh = 0; kh < 2; ++kh)
#pragma unroll
                    for (int s = 0; s < 2; ++s) { if (VAR & 8) { o[db][qb][0] += __uint_as_float(pk[qb][kh][s].x) + __uint_as_float((unsigned)vf[db][kh][s][0]); } else o[db][qb] = __builtin_amdgcn_mfma_f32_32x32x16_bf16(vf[db][kh][s], __builtin_bit_cast(bf16x8, pk[qb][kh][s]), o[db][qb], 0, 0, 0); }
    }
#pragma unroll
    for (int qb = 0; qb < 2; ++qb) {
        const float l = lrun[qb] + __shfl_xor(lrun[qb], 32), inv = 1.0f / l;
        bf16_t* orow = AS + (size_t)(t0 + 32 * qb + r32) * D + 64 * wid + 4 * hi;
#pragma unroll
        for (int db = 0; db < 2; ++db)
#pragma unroll
            for (int g4 = 0; g4 < 4; ++g4) { u32x2 w; w.x = pk_bf16(o[db][qb][4 * g4] * inv, o[db][qb][4 * g4 + 1] * inv); w.y = pk_bf16(o[db][qb][4 * g4 + 2] * inv, o[db][qb][4 * g4 + 3] * inv);
                if (!(VAR & 4) || inv == 12345.678f) *(u32x2*)(orow + 32 * db + 8 * g4) = w; }
    }
}
#undef MX3

__device__ __forceinline__ void sgu_task(int task, const bf16_t* VGT, const bf16_t* UG, const f32x2* stats, const bf16_t* SGWb, const float* R2, const float* bs, const float* lng, const float* lnb,
                                         bf16_t* AS, LAS f32x2* st  , int lane) {
    const int r32 = lane & 31, hi = lane >> 5;
    const int cb = task & 3, g = (task >> 2) & 3, n = task >> 4, tok0 = 128 * n;
    const bf16_t* vrow = VGT + ((size_t)(tok0 >> 4) * 16 + g * 4 + cb) * 512 + lane * 8;
    u32x4 raw[8];
#pragma unroll
    for (int s = 0; s < 8; ++s) raw[s] = *(const u32x4*)(vrow + s * 8192);
#pragma unroll
    for (int j = 0; j < 2; ++j) { const f32x2* sp = stats + (size_t)(tok0 + lane + 64 * j) * 4; const f32x2 a = sp[0], b = sp[1], c = sp[2], d = sp[3];
        const float S = (a.x + b.x) + (c.x + d.x), Q2 = (a.y + b.y) + (c.y + d.y), mu = S * (1.f / SW), var = fmaxf(Q2 * (1.f / SW) - mu * mu, 0.f);
        st[lane + 64 * j] = (f32x2){mu, 1.0f / sqrtf(var + EPS)}; }
    bf16x8 af[8];
#pragma unroll
    for (int s = 0; s < 8; ++s) {
        const LAS f32x4* sp = (const LAS f32x4*)(st + 16 * s + 8 * hi);
        const f32x4 m01 = sp[0], m23 = sp[1], m45 = sp[2], m67 = sp[3];
        u32x4 a;
        a.x = pk_bf16((bf_lo(raw[s].x) - m01[0]) * m01[1], (bf_hi(raw[s].x) - m01[2]) * m01[3]);
        a.y = pk_bf16((bf_lo(raw[s].y) - m23[0]) * m23[1], (bf_hi(raw[s].y) - m23[2]) * m23[3]);
        a.z = pk_bf16((bf_lo(raw[s].z) - m45[0]) * m45[1], (bf_hi(raw[s].z) - m45[2]) * m45[3]);
        a.w = pk_bf16((bf_lo(raw[s].w) - m67[0]) * m67[1], (bf_hi(raw[s].w) - m67[2]) * m67[3]);
        af[s] = __builtin_bit_cast(bf16x8, a);
    }
#pragma unroll
    for (int tp = 0; tp < 2; ++tp) {
        bf16x8 wf[2][8];
#pragma unroll
        for (int tbi = 0; tbi < 2; ++tbi)
#pragma unroll
            for (int s = 0; s < 8; ++s) wf[tbi][s] = *(const bf16x8*)(SGWb + (((g * 4 + 2 * tp + tbi) * 8 + s) * 512) + lane * 8);
#pragma unroll
        for (int tbi = 0; tbi < 2; ++tbi) {
            const int t = 32 * (2 * tp + tbi) + r32;
            const size_t tok = (size_t)(tok0 + t);
            const float r2t = R2[g * 128 + t], bst = bs[g * 128 + t];
            u32x2 ugv[4];
#pragma unroll
            for (int q4 = 0; q4 < 4; ++q4) ugv[q4] = *(const u32x2*)(UG + tok * KP + 128 * g + 32 * cb + 8 * q4 + 4 * hi);
            f32x16 acc;
#pragma unroll
            for (int r = 0; r < 16; ++r) acc[r] = 0.f;
#pragma unroll
            for (int s = 0; s < 8; ++s) acc = __builtin_amdgcn_mfma_f32_32x32x16_bf16(af[s], wf[tbi][s], acc, 0, 0, 0);
#pragma unroll
            for (int q4 = 0; q4 < 4; ++q4) { const int ch = 128 * g + 32 * cb + 8 * q4 + 4 * hi;
                const f32x4 lg = *(const f32x4*)(lng + ch), lb = *(const f32x4*)(lnb + ch);
                const float v0 = bf_lo(ugv[q4].x) * (lg[0] * acc[4 * q4] + lb[0] * r2t + bst), v1 = bf_hi(ugv[q4].x) * (lg[1] * acc[4 * q4 + 1] + lb[1] * r2t + bst);
                const float v2 = bf_lo(ugv[q4].y) * (lg[2] * acc[4 * q4 + 2] + lb[2] * r2t + bst), v3 = bf_hi(ugv[q4].y) * (lg[3] * acc[4 * q4 + 3] + lb[3] * r2t + bst);
                u32x2 w; w.x = pk_bf16(v0, v1); w.y = pk_bf16(v2, v3);
                *(u32x2*)(AS + tok * D + 512 + ch) = w; }
        }
    }
}

constexpr int LDS_BYTES = 147456;
constexpr int MISC_OFF = 131072 + 320;
constexpr int RS_OFF = 131072 + 1024;

__global__ void __launch_bounds__(NTHREADS, 2) mega_fwd(Args args) {
    extern __shared__ __attribute__((aligned(16))) unsigned char lds_raw[];
    LAS unsigned char* lds = (LAS unsigned char*)lds_raw;
    volatile LAS unsigned* MISC = (volatile LAS unsigned*)(lds + MISC_OFF);
    const int tid = threadIdx.x, lane = tid & 63, wid = __builtin_amdgcn_readfirstlane(tid >> 6);
    const int G = gridDim.x, bx = blockIdx.x;
    const int vcu = (G % 8 == 0) ? (bx % 8) * (G / 8) + bx / 8 : bx;
    unsigned char* ws = args.ws;
    unsigned* ctl = (unsigned*)(ws + WS_CTL);
    for (int u = tid; u < (LDS_BYTES - 131072) / 4; u += NTHREADS) ((LAS unsigned*)(lds + 131072))[u] = 0u;
    __syncthreads();
    XcdBarrier bar; bar.bar = ctl + CW_BAR; bar.x = 0; bar.st = nullptr;
    if (MK_LAUNCHES == 1) bar = xcd_barrier_post(ctl + CW_BAR, MISC + 8);
    const int lo = args.ph_lo, hi_ = args.ph_hi;
#ifndef PH_MASK
#define PH_MASK 0x1ff
#endif
#define IN(k) (lo <= (k) && (k) < hi_)
#define PHON(j) ((PH_MASK >> (j)) & 1)
#define SEAM(k) do { if (MK_LAUNCHES == 1 && IN((k) + 1)) xcd_barrier(bar); } while (0)

    const float* x = args.in[0]; float* H = args.out;
#define P_HB   ((bf16_t*)(ws + WS_XN))
#define P_AS   ((bf16_t*)args.out)
#define P_Q    ((bf16_t*)(ws + WS_Q))
#define P_K    ((bf16_t*)(ws + WS_K))
#define P_VT   ((bf16_t*)(ws + WS_VT))
#define P_UG   ((bf16_t*)(ws + WS_UG))
#define P_VGT  ((bf16_t*)(ws + WS_VGT))
#define P_G0   ((unsigned short*)(ws + WS_G0))
#define P_G1   ((unsigned short*)(ws + WS_G1))
#define P_MG   ((bf16_t*)(ws + WS_MG))
#define P_ACT  ((bf16_t*)(ws + WS_ACT))
#define P_STATS ((f32x2*)(ws + WS_STATS))
#define P_SGWB ((bf16_t*)(ws + WS_SGWB))
#define P_R2   ((float*)(ws + WS_R2))
    const int gw = vcu * NWAVES + wid, NGW = G * NWAVES;

    if (PHON(0) && IN(0)) { for (int rep_ = 0; rep_ < (PROBE_REP == 0 ? 2 : 1); ++rep_) {
        LAS float* scr = (LAS float*)(lds + wid * 16384);
        constexpr int I_IN = 16 * 144, I_BA = 8 * 32, I_BS = 8 * 32, I_OUT = 16 * 32, I_FI = 16 * 176, I_FO = 44 * 32, I_LAYER = I_IN + I_BA + I_BS + I_OUT + I_FI + I_FO;
        for (int it = gw; it < DEPTH * I_LAYER; it += NGW) {
            const int l = it / I_LAYER; int r = it % I_LAYER;
            unsigned char* wl = ws + WS_W + (size_t)l * W_LAYER;
            if (r < I_IN) { const int kb = r / 144, nb = r % 144; transpose_item(args.in[2] + (size_t)l * D * INW, INW, (bf16_t*)(wl + W_IN), D, 0, 64 * kb, 32 * nb, 32 * nb, scr, lane, args.in[1] + l * D); continue; } r -= I_IN;
            if (r < I_BA) { const int kb = r / 32, nb = r % 32; transpose_item(args.in[8] + (size_t)l * AW * D, D, (bf16_t*)(wl + W_BR), D, 0, 64 * kb, 32 * nb, 32 * nb, scr, lane); continue; } r -= I_BA;
            if (r < I_BS) { const int kb = r / 32, nb = r % 32; transpose_item(args.in[9] + (size_t)l * SW * D, D, (bf16_t*)(wl + W_BR), D, 512, 64 * kb, 32 * nb, 32 * nb, scr, lane); continue; } r -= I_BS;
            if (r < I_OUT) { const int kb = r / 32, nb = r % 32; transpose_item(args.in[11] + (size_t)l * D * D, D, (bf16_t*)(wl + W_OUT), D, 0, 64 * kb, 32 * nb, 32 * nb, scr, lane); continue; } r -= I_OUT;
            if (r < I_FI) { const int kb = r / 176, nb = r % 176, n0 = 32 * nb;
                const int nn = n0 < DFF ? n0 : n0 - DFF, drow = 256 * (nn / 128) + (nn % 128) + (n0 < DFF ? 0 : 128);
                transpose_item(args.in[13] + (size_t)l * D * 2 * DFF, 2 * DFF, (bf16_t*)(wl + W_FI), D, 0, 64 * kb, n0, drow, scr, lane, args.in[12] + l * D); continue; } r -= I_FI;
            { const int kb = r / 32, nb = r % 32; transpose_item(args.in[14] + (size_t)l * DFF * D, D, (bf16_t*)(wl + W_FO), DFF, 0, 64 * kb, 32 * nb, 32 * nb, scr, lane); }
        }
        for (int row = gw; row < DEPTH * 4 * 128; row += NGW) { const int t = row & 127; const float* wr_ = args.in[6] + (size_t)row * 128;
            const float a = (lane <= t) ? wr_[lane] : 0.f, b = (lane + 64 <= t) ? wr_[lane + 64] : 0.f;
            { const int lg = row >> 7;
              bf16_t* fb = P_SGWB + (size_t)((lg * 4 + (t >> 5)) * 8) * 512 + (t & 31) * 8;
              fb[(lane >> 4) * 512 + ((lane >> 3) & 1) * 256 + (lane & 7)] = (bf16_t)(pk_bf16(a, 0.f) & 0xffffu);
              fb[((lane + 64) >> 4) * 512 + ((lane >> 3) & 1) * 256 + (lane & 7)] = (bf16_t)(pk_bf16(b, 0.f) & 0xffffu); }
            const float s = wave_sum(a + b); if (lane == 0) P_R2[row] = s; }
        for (int m = gw; m < M; m += NGW) copy_row_bf16_ssq(x + (size_t)m * D, P_HB + (size_t)m * D, (float*)(ws + WS_SSQ) + (size_t)m * 16, lane);
        }
        SEAM(0);
    }
    for (int l = 0; l < DEPTH; ++l) {
        const int pb = 1 + 8 * l;
        unsigned char* wl = ws + WS_W + (size_t)l * W_LAYER;
        if (PHON(1) && IN(pb + 0)) { for (int rep_ = 0; rep_ < (PROBE_REP == pb + 0 ? 2 : 1); ++rep_) {
            load_rstd((LAS float*)(lds + RS_OFF), (const float*)(ws + WS_SSQ), bx & 7, threadIdx.x);
            Sched1 S{P_HB, (const bf16_t*)(wl + W_IN), G, bx};
            Epi1 E{ws, args.in[10] + (size_t)l * 2 * D, (const LAS float*)(lds + RS_OFF), 2048 * (bx & 7)};
            pg8::gemm_phase<Epi1, Sched1>(lds, D, S, E);
            }
            SEAM(pb + 0);
        }
        if (PHON(2) && IN(pb + 1)) { for (int rep_ = 0; rep_ < (PROBE_REP == pb + 1 ? 2 : 1); ++rep_) {
            int tid = threadIdx.x; asm volatile("" : "+v"(tid));
            const int lane = tid & 63, wid = __builtin_amdgcn_readfirstlane(tid >> 6);
            if (rep_ == 1 && PROBE_SUB >= 16) { for (int uu = vcu; uu < 256; uu += G) attn_unit<(PROBE_SUB & 15) | 4>(uu >> 6, uu & 63, P_Q, P_K, P_VT, P_AS, args.in[3] + (size_t)l * NH * 257, (LAS float*)(lds + wid * TAB_BYTES), lds + 65536 + wid * 8192, wid, lane); }
            else if (rep_ == 0 || PROBE_SUB != 2) for (int uu = vcu; uu < 256; uu += G) attn_unit<0>(uu >> 6, uu & 63, P_Q, P_K, P_VT, P_AS, args.in[3] + (size_t)l * NH * 257, (LAS float*)(lds + wid * TAB_BYTES), lds + 65536 + wid * 8192, wid, lane);
            if (rep_ == 0 || (PROBE_SUB != 1 && PROBE_SUB < 16)) for (int task = vcu * NWAVES + wid; task < 2048; task += G * NWAVES) sgu_task(task, P_VGT, P_UG, P_STATS, P_SGWB + (size_t)l * 4 * 128 * 128, P_R2 + l * 512, args.in[7] + l * 512, args.in[4] + l * SW, args.in[5] + l * SW,
                                                           P_AS, (LAS f32x2*)(lds + 49152 + wid * 1024), lane);
            }
            SEAM(pb + 1);
        }
        if (PHON(3) && IN(pb + 2)) { for (int rep_ = 0; rep_ < (PROBE_REP == pb + 2 ? 2 : 1); ++rep_) {
            SchedN S{P_AS, (const bf16_t*)(wl + W_BR), D, 4, 256, G, bx};
            Epi2 E{P_G0, P_G1, P_MG};
            pg8::gemm_phase<Epi2, SchedN>(lds, D, S, E);
            }
            SEAM(pb + 2);
        }
        if (PHON(4) && IN(pb + 3)) { for (int rep_ = 0; rep_ < (PROBE_REP == pb + 3 ? 2 : 1); ++rep_) {
            SchedN S{P_MG, (const bf16_t*)(wl + W_OUT), D, 4, 256, G, bx};
            Epi3 E{rep_ == 0 ? P_HB : (bf16_t*)(ws + 184 * MiB), rep_ == 0 ? (float*)(ws + WS_SSQ) : (float*)(ws + 244 * MiB)};
            pg8::gemm_phase<Epi3, SchedN>(lds, D, S, E);
            }
            SEAM(pb + 3);
        }
        if (PHON(6) && IN(pb + 5)) { for (int rep_ = 0; rep_ < (PROBE_REP == pb + 5 ? 2 : 1); ++rep_) {
            load_rstd((LAS float*)(lds + RS_OFF), (const float*)(ws + WS_SSQ), bx & 7, threadIdx.x);
            SchedN S{P_HB, (const bf16_t*)(wl + W_FI), D, 22, 128, G, bx};
            Epi4 E{P_ACT, (const LAS float*)(lds + RS_OFF), 2048 * (bx & 7)};
            pg8::gemm_phase<Epi4, SchedN>(lds, D, S, E);
            }
            SEAM(pb + 5);
        }
        if (PHON(7) && IN(pb + 6)) { for (int rep_ = 0; rep_ < (PROBE_REP == pb + 6 ? 2 : 1); ++rep_) {
            SchedN S{P_ACT, (const bf16_t*)(wl + W_FO), DFF, 4, 256, G, bx};
            Epi3 E{rep_ == 0 ? P_HB : (bf16_t*)(ws + 184 * MiB), rep_ == 0 ? (float*)(ws + WS_SSQ) : (float*)(ws + 244 * MiB)};
            pg8::gemm_phase<Epi3, SchedN>(lds, DFF, S, E);
            }
            SEAM(pb + 6);
        }
        if (PHON(8) && IN(pb + 7) && l + 1 == DEPTH) {
            int lane = threadIdx.x & 63; asm volatile("" : "+v"(lane));
            for (int m = gw; m < M; m += NGW) final_row(P_HB + (size_t)m * D, (const float*)(ws + WS_SSQ) + (size_t)m * 16, args.in[15], H + (size_t)m * D, lane);
        }
    }
    if (MK_LAUNCHES == 1) for (int i_ = 0; i_ < PROBE_BARS; ++i_) xcd_barrier(bar);
#undef IN
#undef SEAM
}

extern "C" void kernel_launch(void* const* d_in, const int* in_sizes, int n_in, void* d_out, int out_size, void* d_ws, size_t ws_size, hipStream_t stream) {
    static int grid = 0;
    if (grid == 0) {
        if (n_in != 16 || out_size != M * D || ws_size < WS_END) { fprintf(stderr, "kernel_launch: unexpected shapes (n_in %d, out %d, ws %zu)\n", n_in, out_size, ws_size); grid = -1; return; }
        int dev = 0, cus = 0, per_cu = 0;
        if (hipGetDevice(&dev) != hipSuccess || hipDeviceGetAttribute(&cus, hipDeviceAttributeMultiprocessorCount, dev) != hipSuccess) { grid = -1; return; }
        if (hipFuncSetAttribute((const void*)mega_fwd, hipFuncAttributeMaxDynamicSharedMemorySize, LDS_BYTES) != hipSuccess) { fprintf(stderr, "kernel_launch: hipFuncSetAttribute failed\n"); grid = -1; return; }
        if (hipOccupancyMaxActiveBlocksPerMultiprocessor(&per_cu, (const void*)mega_fwd, NTHREADS, LDS_BYTES) != hipSuccess || per_cu < 1) { fprintf(stderr, "kernel_launch: occupancy query says %d blocks per CU\n", per_cu); (void)hipGetLastError(); grid = -1; return; }
        grid = cus;
        if (grid % 8 != 0) { fprintf(stderr, "kernel_launch: %d CUs: the unit orders assume a multiple of 8\n", grid); grid = -1; return; }
    }
    if (grid < 0) return;
    (void)hipMemsetAsync((char*)d_ws + WS_CTL, 0, CTL_ZERO_BYTES, stream);
    Args a{};
    for (int i = 0; i < 16; ++i) a.in[i] = (const float*)d_in[i];
    a.out = (float*)d_out; a.ws = (unsigned char*)d_ws;
    constexpr int NPH = 1 + 8 * DEPTH;
    if (MK_LAUNCHES == 1) { a.ph_lo = 0; a.ph_hi = NPH; hipLaunchKernelGGL(mega_fwd, dim3(grid), dim3(NTHREADS), LDS_BYTES, stream, a); }
    else for (int p = 0; p < NPH; ++p) { a.ph_lo = p; a.ph_hi = p + 1; hipLaunchKernelGGL(mega_fwd, dim3(grid), dim3(NTHREADS), LDS_BYTES, stream, a); }
}
```
